# Optimizing an MI355X kernel written in HIP

```python
import jax, jax.numpy as jnp
from jax import lax
import numpy as np

D_MODEL = 1024
BATCH = 2
SEQ = 8192
DEPTH = 4

N_MIXERS = 2
N_MLSTM_LAYERS = (DEPTH + N_MIXERS - 1) // N_MIXERS
N_ATTN_LAYERS = DEPTH // N_MIXERS

MLSTM_HEADS = 4
MLSTM_QK_DIM = D_MODEL // (2 * MLSTM_HEADS)
MLSTM_V_DIM = D_MODEL // MLSTM_HEADS
MLSTM_CHUNK = 128
MLSTM_N_GATES = 4 * MLSTM_HEADS
MLSTM_IN_WIDTH = 2 * MLSTM_HEADS * MLSTM_QK_DIM + 2 * D_MODEL + MLSTM_N_GATES
FGATE_BIAS_LO = 3.0
FGATE_BIAS_HI = 6.0

ATTN_HEAD_DIM = 64
ATTN_Q_HEADS = D_MODEL // ATTN_HEAD_DIM
ATTN_KV_HEADS = 4
ATTN_GROUP = ATTN_Q_HEADS // ATTN_KV_HEADS
WINDOW = 128
ATTN_BLOCK = 128
ATTN_IN_WIDTH = (ATTN_Q_HEADS + 2 * ATTN_KV_HEADS) * ATTN_HEAD_DIM
ROPE_THETA = 10000.0

D_FF = -(-(8 * D_MODEL) // (3 * 256)) * 256
EPS = 1e-6

kernel_name = "bidir_mlstm_swa_hybrid_trunk"


def rmsnorm(x, w):
    xf = x.astype(jnp.float32)
    y = xf * lax.rsqrt(jnp.mean(xf * xf, axis=-1, keepdims=True) + EPS)
    return (y * w.astype(jnp.float32)).astype(x.dtype)


def rope(x, positions):
    half = x.shape[-1] // 2
    inv_freq = ROPE_THETA ** (-jnp.arange(half, dtype=jnp.float32) / half)
    ang = positions.astype(jnp.float32)[..., None] * inv_freq
    cos = jnp.cos(ang)[:, :, None, :]
    sin = jnp.sin(ang)[:, :, None, :]
    xf = x.astype(jnp.float32)
    x1, x2 = xf[..., :half], xf[..., half:]
    return jnp.concatenate([x1 * cos - x2 * sin, x2 * cos + x1 * sin], axis=-1)


def mlstm_chunkwise(q, k, v, log_i, log_f):
    B, H, S, dk = q.shape
    dv = v.shape[-1]
    L = MLSTM_CHUNK
    NC = S // L
    q = q.reshape(B, H, NC, L, dk)
    k = k.reshape(B, H, NC, L, dk)
    v = v.reshape(B, H, NC, L, dv)
    log_i = log_i.reshape(B, H, NC, L)
    b = jnp.cumsum(log_f.reshape(B, H, NC, L), axis=-1)
    b_last = b[..., -1]

    a = b_last[..., None] - b + log_i
    a_max = jnp.max(a, axis=-1)
    w = jnp.exp(a - a_max[..., None])
    kv_chunk = jnp.einsum('bhcl,bhcld,bhcle->bhcde', w, k, v)
    k_chunk = jnp.einsum('bhcl,bhcld->bhcd', w, k)

    def step(carry, xs):
        C, n, m = carry
        kv_c, k_c, bl_c, am_c = xs
        m_new = jnp.maximum(bl_c + m, am_c)
        s_prev = jnp.exp(bl_c + m - m_new)
        s_cur = jnp.exp(am_c - m_new)
        C_new = s_prev[..., None, None] * C + s_cur[..., None, None] * kv_c
        n_new = s_prev[..., None] * n + s_cur[..., None] * k_c
        return (C_new, n_new, m_new), (C, n, m)

    init = (jnp.zeros((B, H, dk, dv), jnp.float32),
            jnp.zeros((B, H, dk), jnp.float32),
            jnp.zeros((B, H), jnp.float32))
    xs = (jnp.moveaxis(kv_chunk, 2, 0), jnp.moveaxis(k_chunk, 2, 0),
          jnp.moveaxis(b_last, 2, 0), jnp.moveaxis(a_max, 2, 0))
    _, (C_prev, n_prev, m_prev) = lax.scan(step, init, xs)
    C_prev = jnp.moveaxis(C_prev, 0, 2)
    n_prev = jnp.moveaxis(n_prev, 0, 2)
    m_prev = jnp.moveaxis(m_prev, 0, 2)

    tril = jnp.tril(jnp.ones((L, L), dtype=bool))
    D = b[..., :, None] - b[..., None, :] + log_i[..., None, :]
    D = jnp.where(tril, D, -jnp.inf)
    g = b + m_prev[..., None]
    m_t = jnp.maximum(g, jnp.max(D, axis=-1))
    s = jnp.einsum('bhcld,bhcsd->bhcls', q, k) * jnp.exp(D - m_t[..., None])
    inter = jnp.exp(g - m_t)
    num = (jnp.einsum('bhcls,bhcse->bhcle', s, v)
           + inter[..., None] * jnp.einsum('bhcld,bhcde->bhcle', q, C_prev))
    den = jnp.sum(s, axis=-1) + inter * jnp.einsum('bhcld,bhcd->bhcl', q, n_prev)
    den = jnp.maximum(jnp.abs(den), jnp.exp(-m_t))
    return (num / den[..., None]).reshape(B, H, S, dv)


def mlstm_mixer(h, w_in, b_gate, norm_w, w_out):
    B, S, _ = h.shape
    H, dk, dv = MLSTM_HEADS, MLSTM_QK_DIM, MLSTM_V_DIM
    proj = h @ w_in
    o1 = H * dk
    o2 = 2 * H * dk
    o3 = o2 + D_MODEL
    o4 = o3 + D_MODEL
    q = proj[..., :o1].reshape(B, S, H, dk).transpose(0, 2, 1, 3).astype(jnp.float32) * (dk ** -0.5)
    k = proj[..., o1:o2].reshape(B, S, H, dk).transpose(0, 2, 1, 3).astype(jnp.float32)
    v = proj[..., o2:o3].reshape(B, S, H, dv).transpose(0, 2, 1, 3).astype(jnp.float32)
    o_gate = jax.nn.sigmoid(proj[..., o3:o4].astype(jnp.float32))
    gates = (proj[..., o4:] + b_gate).astype(jnp.float32)
    gates = gates.reshape(B, S, 4, H).transpose(2, 0, 3, 1)
    i_fwd, f_fwd, i_bwd, f_bwd = gates[0], gates[1], gates[2], gates[3]

    h_fwd = mlstm_chunkwise(q, k, v, i_fwd, jax.nn.log_sigmoid(f_fwd))
    flip = lambda t: t[:, :, ::-1]
    h_bwd = flip(mlstm_chunkwise(flip(q), flip(k), flip(v), flip(i_bwd),
                                 flip(jax.nn.log_sigmoid(f_bwd))))
    hs = h_fwd + h_bwd
    hs = hs * lax.rsqrt(jnp.mean(hs * hs, axis=-1, keepdims=True) + EPS)
    hs = hs.transpose(0, 2, 1, 3).reshape(B, S, H * dv) * norm_w.astype(jnp.float32)
    return (hs * o_gate).astype(h.dtype) @ w_out


def window_attn_mixer(h, positions, w_in, sink, w_out):
    B, S, _ = h.shape
    Hq, Hkv, G, hd, L = ATTN_Q_HEADS, ATTN_KV_HEADS, ATTN_GROUP, ATTN_HEAD_DIM, ATTN_BLOCK
    NB = S // L
    proj = h @ w_in
    q = proj[..., :Hq * hd].reshape(B, S, Hq, hd)
    k = proj[..., Hq * hd:(Hq + Hkv) * hd].reshape(B, S, Hkv, hd)
    v = proj[..., (Hq + Hkv) * hd:].reshape(B, S, Hkv, hd)
    q = rope(q, positions).reshape(B, NB, L, Hkv, G, hd)
    k = rope(k, positions)

    def band(t):
        tp = jnp.pad(t, ((0, 0), (L, L), (0, 0), (0, 0))).reshape(B, NB + 2, L, Hkv, hd)
        return jnp.concatenate([tp[:, :-2], tp[:, 1:-1], tp[:, 2:]], axis=2)

    k_band = band(k)
    v_band = band(v).astype(jnp.float32)
    scores = jnp.einsum('bcqhgd,bckhd->bchgqk', q, k_band) * (hd ** -0.5)

    qi = jnp.arange(L)
    kj = jnp.arange(3 * L)
    in_window = jnp.abs(kj[None, :] - L - qi[:, None]) <= WINDOW
    k_pos = jnp.arange(NB)[:, None] * L - L + kj[None, :]
    k_valid = (k_pos >= 0) & (k_pos < S)
    mask = in_window[None, :, :] & k_valid[:, None, :]
    scores = jnp.where(mask[None, :, None, None], scores, -jnp.inf)

    sink_l = sink.astype(jnp.float32).reshape(Hkv, G)[None, None, :, :, None]
    m = jnp.maximum(jnp.max(scores, axis=-1), sink_l)
    p = jnp.exp(scores - m[..., None])
    denom = jnp.sum(p, axis=-1) + jnp.exp(sink_l - m)
    out = jnp.einsum('bchgqk,bckhd->bcqhgd', p, v_band)
    out = out / denom.transpose(0, 1, 4, 2, 3)[..., None]
    return out.reshape(B, S, Hq * hd).astype(h.dtype) @ w_out


def swiglu(h, w_in, w_out):
    gu = h @ w_in
    gate, up = gu[..., :D_FF], gu[..., D_FF:]
    return (jax.nn.silu(gate) * up) @ w_out


def setup_inputs(seed: int = 0) -> dict:
    key = jax.random.key(seed)
    ks = jax.random.split(key, 16)
    f32 = jnp.float32

    def w(k, shape, fan_in):
        return jax.random.normal(k, shape, f32) * (fan_in ** -0.5)

    x = jax.random.normal(ks[0], (BATCH, SEQ, D_MODEL), f32)
    positions = jnp.broadcast_to(jnp.arange(SEQ, dtype=jnp.int32), (BATCH, SEQ))
    norm_mix_w = 1.0 + 0.02 * jax.random.normal(ks[1], (DEPTH, D_MODEL), f32)
    norm_ffn_w = 1.0 + 0.02 * jax.random.normal(ks[2], (DEPTH, D_MODEL), f32)
    norm_final_w = 1.0 + 0.02 * jax.random.normal(ks[3], (D_MODEL,), f32)

    mlstm_w_in = w(ks[4], (N_MLSTM_LAYERS, D_MODEL, MLSTM_IN_WIDTH), D_MODEL)
    fbias = jnp.linspace(FGATE_BIAS_LO, FGATE_BIAS_HI, MLSTM_HEADS, dtype=f32)
    base = jnp.stack([jnp.zeros_like(fbias), fbias, jnp.zeros_like(fbias), fbias], axis=0)
    mlstm_b_gate = (base[None] + 0.1 * jax.random.normal(ks[5], (N_MLSTM_LAYERS, 4, MLSTM_HEADS), f32)
                    ).reshape(N_MLSTM_LAYERS, MLSTM_N_GATES)
    mlstm_norm_w = 1.0 + 0.02 * jax.random.normal(ks[6], (N_MLSTM_LAYERS, D_MODEL), f32)
    mlstm_w_out = w(ks[7], (N_MLSTM_LAYERS, D_MODEL, D_MODEL), D_MODEL)

    attn_w_in = w(ks[8], (N_ATTN_LAYERS, D_MODEL, ATTN_IN_WIDTH), D_MODEL)
    attn_sink = 0.5 * jax.random.normal(ks[9], (N_ATTN_LAYERS, ATTN_Q_HEADS), f32)
    attn_w_out = w(ks[10], (N_ATTN_LAYERS, ATTN_Q_HEADS * ATTN_HEAD_DIM, D_MODEL), ATTN_Q_HEADS * ATTN_HEAD_DIM)

    ffn_w_in = w(ks[11], (DEPTH, D_MODEL, 2 * D_FF), D_MODEL)
    ffn_w_out = w(ks[12], (DEPTH, D_FF, D_MODEL), D_FF)
    return {"x": x, "positions": positions, "norm_mix_w": norm_mix_w, "norm_ffn_w": norm_ffn_w,
            "norm_final_w": norm_final_w, "mlstm_w_in": mlstm_w_in, "mlstm_b_gate": mlstm_b_gate,
            "mlstm_norm_w": mlstm_norm_w, "mlstm_w_out": mlstm_w_out, "attn_w_in": attn_w_in,
            "attn_sink": attn_sink, "attn_w_out": attn_w_out, "ffn_w_in": ffn_w_in,
            "ffn_w_out": ffn_w_out}


def reference(x, positions, norm_mix_w, norm_ffn_w, norm_final_w, mlstm_w_in, mlstm_b_gate,
              mlstm_norm_w, mlstm_w_out, attn_w_in, attn_sink, attn_w_out, ffn_w_in, ffn_w_out):
    for i in range(DEPTH):
        j = i // N_MIXERS
        hn = rmsnorm(x, norm_mix_w[i])
        if i % N_MIXERS == 0:
            x = x + mlstm_mixer(hn, mlstm_w_in[j], mlstm_b_gate[j], mlstm_norm_w[j], mlstm_w_out[j])
        else:
            x = x + window_attn_mixer(hn, positions, attn_w_in[j], attn_sink[j], attn_w_out[j])
        x = x + swiglu(rmsnorm(x, norm_ffn_w[i]), ffn_w_in[i], ffn_w_out[i])
    return rmsnorm(x, norm_final_w)
```

```cpp
#include <hip/hip_runtime.h>
#include <cstdio>
#include <cstdint>
#include <cmath>
namespace pg8 {
#define PG8_LAS __attribute__((address_space(3)))
typedef unsigned short bf16_t;
typedef short bf16x8 __attribute__((ext_vector_type(8)));
typedef float f32x4 __attribute__((ext_vector_type(4)));
typedef unsigned u32x4 __attribute__((ext_vector_type(4)));
constexpr int BM = 256, BK = 64, HALF = 128, HTB = HALF * BK * 2  , STAGE_BYTES = 8 * HTB, NXCD = 8, WGM = 8;

__host__ __device__ __forceinline__ int lds_byte(int r, int c) { const int st = (r >> 4) * 2 + (c >> 5), rr = r & 15, cc = c & 31, ob = rr * 64 + cc * 2; return st * 1024 + (ob ^ (((ob >> 9) & 1) << 5)); }
__host__ __device__ __forceinline__ void stage_rc(int b, int& R, int& C) { const int st = b / 1024, sb = b % 1024, swz = sb ^ (((sb >> 9) & 1) << 5); R = (st >> 1) * 16 + swz / 64; C = (st & 1) * 32 + (swz % 64) / 2; }
__host__ __device__ __forceinline__ int perm32(int rho) { const int n = rho >> 4, i = rho & 15; return 8 * (i >> 2) + 4 * n + (i & 3); }

struct Unit { int pm, pn; };
struct Gemm { const bf16_t* A; const bf16_t* Bt; int M, N, K; };

struct StaticOrder {
    int nM, nN, nwg, G, c;
    __host__ __device__ void init(int M, int N, int G_, int c_) { nM = M / BM; nN = N / BM; nwg = nM * nN; G = G_; c = c_; }
    __host__ __device__ bool next(int i, Unit& u) const {
        const long L = (long)i * G + c; if (L >= nwg) return false;
        int wgid = (int)L; { const int q = nwg / NXCD, r = nwg % NXCD, xcd = wgid % NXCD, off = wgid / NXCD; wgid = (xcd < r ? xcd * (q + 1) : r * (q + 1) + (xcd - r) * q) + off; }
        const int nig = WGM * nN, gid = wgid / nig, fm = gid * WGM, gsz = (nM - fm) < WGM ? (nM - fm) : WGM;
        u.pm = fm + ((wgid % nig) % gsz); u.pn = (wgid % nig) / gsz; return true;
    }
    __device__ __forceinline__ void a_ready(const Unit&) const {}
    __device__ __forceinline__ void done(const Unit&) const {}
};

__device__ __forceinline__ unsigned cvt_pk_bf16(float lo, float hi) { unsigned r; asm volatile("v_cvt_pk_bf16_f32 %0, %1, %2" : "=v"(r) : "v"(lo), "v"(hi)); return r; }
typedef float f32x2 __attribute__((ext_vector_type(2)));

constexpr int EP_M = 16384;
constexpr float EP_EPS = 1e-6f;
typedef unsigned u32x2 __attribute__((ext_vector_type(2)));

template <int K> __device__ __forceinline__ float shx(float v) { static_assert(K == 1 || K == 2 || K == 4 || K == 8 || K == 16, "xor mask"); return __int_as_float(__builtin_amdgcn_ds_swizzle(__float_as_int(v), 0x1F | (K << 10))); }
__device__ __forceinline__ float xhalf_sum(float v) { auto rr = __builtin_amdgcn_permlane32_swap(__float_as_uint(v), __float_as_uint(v), false, false); return __uint_as_float(rr[0]) + __uint_as_float(rr[1]); }
__device__ __forceinline__ float xhalf_max(float v) { auto rr = __builtin_amdgcn_permlane32_swap(__float_as_uint(v), __float_as_uint(v), false, false); return fmaxf(__uint_as_float(rr[0]), __uint_as_float(rr[1])); }
__device__ __forceinline__ void row_rstd(const float* part, int row0  , int fq, float (&rs)[2][4]) {
#pragma unroll
    for (int ai = 0; ai < 2; ++ai)
#pragma unroll
        for (int m = 0; m < 4; ++m) {
            const unsigned row = (unsigned)(row0 + ai * HALF + m * 16);
            const f32x4 pv = *(const f32x4*)((const char*)part + (row * 64u + (unsigned)fq * 16u));
            float s = (pv[0] + pv[1]) + (pv[2] + pv[3]);
            s += shx<16>(s); s = xhalf_sum(s);
            rs[ai][m] = rsqrtf(s * (1.0f / 1024.0f) + EP_EPS);
        }
}
template <bool ROPE> struct EpiProj {
    static constexpr bool PERM = true, AFTER_DRAIN = false;
    bf16_t* O; int ldc; const float* part; const float* cosT; const float* sinT;
    __device__ __forceinline__ void operator()(const f32x4 (&acc)[2][2][4][2], const Unit& u, int wr, int wc, int fr, int fq) const {
        const int row0 = u.pm * BM + wr * 64 + fr;
        float rs[2][4]; row_rstd(part, row0, fq, rs);
        const int col0 = u.pn * BM + wc * 32 + 8 * fq;
        const int i0 = (wc & 1) * 16 + 4 * fq;
        const bool rope = ROPE && (u.pn < 5);
#pragma unroll
        for (int ai = 0; ai < 2; ++ai)
#pragma unroll
            for (int m = 0; m < 4; ++m) {
                const int row = row0 + ai * HALF + m * 16;
                bf16_t* rowp = (bf16_t*)((char*)O + ((unsigned)row * (unsigned)ldc + (unsigned)col0) * 2u);
                const float r = rs[ai][m];
                f32x4 cs = {1.f, 1.f, 1.f, 1.f}, sn = {0.f, 0.f, 0.f, 0.f};
                if (rope) { const unsigned to = ((unsigned)row * 32u + (unsigned)i0) * 4u; cs = *(const f32x4*)((const char*)cosT + to); sn = *(const f32x4*)((const char*)sinT + to); }
#pragma unroll
                for (int bj = 0; bj < 2; ++bj) {
                    f32x4 v0 = acc[ai][bj][m][0] * r, v1 = acc[ai][bj][m][1] * r;
                    if (ROPE) {
                        const f32x4 a = v0, b = v1;
                        v0[0] = a[0] * cs[0] - a[1] * sn[0]; v0[1] = a[1] * cs[0] + a[0] * sn[0];
                        v0[2] = a[2] * cs[1] - a[3] * sn[1]; v0[3] = a[3] * cs[1] + a[2] * sn[1];
                        v1[0] = b[0] * cs[2] - b[1] * sn[2]; v1[1] = b[1] * cs[2] + b[0] * sn[2];
                        v1[2] = b[2] * cs[3] - b[3] * sn[3]; v1[3] = b[3] * cs[3] + b[2] * sn[3];
                    }
                    u32x4 w; w.x = cvt_pk_bf16(v0[0], v0[1]); w.y = cvt_pk_bf16(v0[2], v0[3]); w.z = cvt_pk_bf16(v1[0], v1[1]); w.w = cvt_pk_bf16(v1[2], v1[3]);
                    *(u32x4*)(rowp + bj * HALF) = w;
                }
            }
    }
};
struct EpiSwiGLU {
    static constexpr bool PERM = true, AFTER_DRAIN = false;
    bf16_t* O; int ldc; const float* part;
    __device__ __forceinline__ void operator()(const f32x4 (&acc)[2][2][4][2], const Unit& u, int wr, int wc, int fr, int fq) const {
        const int row0 = u.pm * BM + wr * 64 + fr;
        float rs[2][4]; row_rstd(part, row0, fq, rs);
        const int col0 = u.pn * HALF + wc * 32 + 8 * fq;
#pragma unroll
        for (int ai = 0; ai < 2; ++ai)
#pragma unroll
            for (int m = 0; m < 4; ++m) {
                const int row = row0 + ai * HALF + m * 16;
                const float r = rs[ai][m];
                float h[8];
#pragma unroll
                for (int n = 0; n < 2; ++n)
#pragma unroll
                    for (int c = 0; c < 4; ++c) {
                        const float g = acc[ai][0][m][n][c] * r, uu = acc[ai][1][m][n][c] * r;
                        h[n * 4 + c] = g * __builtin_amdgcn_rcpf(1.0f + __builtin_amdgcn_exp2f(-1.4426950408889634f * g)) * uu;
                    }
                u32x4 w; w.x = cvt_pk_bf16(h[0], h[1]); w.y = cvt_pk_bf16(h[2], h[3]); w.z = cvt_pk_bf16(h[4], h[5]); w.w = cvt_pk_bf16(h[6], h[7]);
                *(u32x4*)((char*)O + ((unsigned)row * (unsigned)ldc + (unsigned)col0) * 2u) = w;
            }
    }
};
struct EpiResid {
    static constexpr bool PERM = false, AFTER_DRAIN = false;
    float* X; bf16_t* XB; float* part;
    __device__ __forceinline__ void operator()(const f32x4 (&acc)[2][2][4][2], const Unit& u, int wr, int wc, int fr, int fq) const {
        const int row0 = u.pm * BM + wr * 64 + fr, col0 = u.pn * BM + wc * 32 + 4 * fq;
#pragma unroll
        for (int ai = 0; ai < 2; ++ai)
#pragma unroll
            for (int m = 0; m < 4; ++m) {
                const int row = row0 + ai * HALF + m * 16;
                float ss = 0.f;
#pragma unroll
                for (int bj = 0; bj < 2; ++bj)
#pragma unroll
                    for (int n = 0; n < 2; ++n) {
                        const unsigned off = (unsigned)row * 1024u + (unsigned)(col0 + bj * HALF + n * 16);
                        float* xp = (float*)((char*)X + off * 4u);
                        const f32x4 o = *(const f32x4*)xp + acc[ai][bj][m][n];
                        *(f32x4*)xp = o;
                        u32x2 w; w.x = cvt_pk_bf16(o[0], o[1]); w.y = cvt_pk_bf16(o[2], o[3]);
                        *(u32x2*)((char*)XB + off * 2u) = w;
                        ss += (o[0] * o[0] + o[1] * o[1]) + (o[2] * o[2] + o[3] * o[3]);
                    }
                ss += shx<16>(ss); ss = xhalf_sum(ss);
                if (fq == 0) *(float*)((char*)part + ((unsigned)row * 64u + (unsigned)(4 * u.pn + wc) * 4u)) = ss;
            }
    }
};
template <class Epi, class Sched, bool ALIGN_EPI = false, bool SP2 = false>
__device__ __forceinline__ void gemm_phase(PG8_LAS unsigned char* lds, const Gemm g, const Sched& S, const Epi& E, const int wave_in) {
    int tid_; asm volatile("v_mbcnt_lo_u32_b32 %0, -1, 0\n\tv_mbcnt_hi_u32_b32 %0, -1, %0" : "=v"(tid_)); tid_ += wave_in * 64; asm volatile("" : "+v"(tid_));
    const int tid = tid_, wid = __builtin_amdgcn_readfirstlane(tid >> 6), lane = tid & 63, wr = wid >> 2, wc = wid & 3, fr = lane & 15, fq = lane >> 4;
    const int K = g.K, nt = K / BK;
    unsigned voffA[2], voffB[2];
#pragma unroll
    for (int i = 0; i < 2; ++i) { int R, C; stage_rc(tid * 16 + i * 8192, R, C); const int Rb = Epi::PERM ? ((R & ~31) + perm32(R & 31)) : R;
        voffA[i] = (unsigned)(R * K + C) * 2u; voffB[i] = (unsigned)(Rb * K + C) * 2u; }
    const size_t kstep = (size_t)(BK * 2);
    const size_t hstep = (size_t)HALF * K * 2;
    const size_t tstep = 2 * hstep;
    const unsigned ldsw = (unsigned)wid * 1024u;
    const int aoff = lds_byte(wr * 64 + fr, fq * 8), boff = lds_byte(wc * 32 + fr, fq * 8);
#define PG8_SA(b, h) (((b) * 2 + (h)) * HTB)
#define PG8_SB(b, h) ((4 + (b) * 2 + (h)) * HTB)
#define PG8_STAGE(bufoff, gbase, voff) do { _Pragma("unroll") for (int _i = 0; _i < 2; ++_i) \
        __builtin_amdgcn_global_load_lds((const unsigned*)((const char*)(gbase) + (voff)[_i]), (PG8_LAS unsigned*)(lds + (bufoff) + ldsw + _i * 8192), 16, 0, 0); } while (0)
#define PG8_LDA(dst, b, h) do { _Pragma("unroll") for (int m = 0; m < 4; ++m) _Pragma("unroll") for (int k = 0; k < 2; ++k) dst[m][k] = *(const PG8_LAS bf16x8*)(lds + PG8_SA(b, h) + aoff + m * 2048 + k * 1024); } while (0)
#define PG8_LDB(dst, b, h) do { _Pragma("unroll") for (int n = 0; n < 2; ++n) _Pragma("unroll") for (int k = 0; k < 2; ++k) dst[n][k] = *(const PG8_LAS bf16x8*)(lds + PG8_SB(b, h) + boff + n * 2048 + k * 1024); } while (0)
#define PG8_MMA(ai, bj, At, Bt) do { __builtin_amdgcn_s_setprio(1); _Pragma("unroll") for (int m = 0; m < 4; ++m) _Pragma("unroll") for (int n = 0; n < 2; ++n) _Pragma("unroll") for (int k = 0; k < 2; ++k) \
        acc[ai][bj][m][n] = __builtin_amdgcn_mfma_f32_16x16x32_bf16(Bt[n][k], At[m][k], acc[ai][bj][m][n], 0, 0, 0); __builtin_amdgcn_s_setprio(0); } while (0)
#define PG8_WAIT_V(n) asm volatile("s_waitcnt vmcnt(" #n ")" ::: "memory")
#define PG8_WAIT_L(n) asm volatile("s_waitcnt lgkmcnt(" #n ")" ::: "memory")
#define PG8_BAR __builtin_amdgcn_s_barrier()
#define PG8_SCHED __builtin_amdgcn_sched_barrier(0)
    Unit cur, nxt; int ui = 0;
    if (!S.next(0, cur)) return;
    f32x4 acc[2][2][4][2];
#pragma unroll
    for (int a = 0; a < 2; ++a)
#pragma unroll
        for (int b = 0; b < 2; ++b)
#pragma unroll
            for (int m = 0; m < 4; ++m)
#pragma unroll
                for (int n = 0; n < 2; ++n) acc[a][b][m][n] = (f32x4){0.f, 0.f, 0.f, 0.f};
    bf16x8 At[4][2], B0[2][2], B1[2][2];
    const char* cA = (const char*)g.A + (size_t)cur.pm * tstep; const char* cB = (const char*)g.Bt + (size_t)cur.pn * tstep;
    S.a_ready(cur);
    if constexpr (SP2) {
        PG8_STAGE(PG8_SB(0, 0), cB, voffB); PG8_STAGE(PG8_SB(0, 1), cB + hstep, voffB); PG8_STAGE(PG8_SA(0, 0), cA, voffA); PG8_STAGE(PG8_SA(0, 1), cA + hstep, voffA);
        if (wr == 1) PG8_BAR;
        PG8_WAIT_V(2); PG8_BAR;
        PG8_STAGE(PG8_SB(1, 0), cB + kstep, voffB); PG8_STAGE(PG8_SA(1, 0), cA + kstep, voffA); PG8_STAGE(PG8_SB(1, 1), cB + hstep + kstep, voffB);
        PG8_WAIT_V(6); PG8_BAR;
    } else {
        PG8_STAGE(PG8_SB(0, 0), cB, voffB); PG8_STAGE(PG8_SA(0, 0), cA, voffA); PG8_STAGE(PG8_SB(0, 1), cB + hstep, voffB); PG8_STAGE(PG8_SA(0, 1), cA + hstep, voffA);
        if (wr == 1) PG8_BAR;
        PG8_WAIT_V(4); PG8_BAR;
        PG8_STAGE(PG8_SB(1, 0), cB + kstep, voffB); PG8_STAGE(PG8_SA(1, 0), cA + kstep, voffA); PG8_STAGE(PG8_SB(1, 1), cB + hstep + kstep, voffB);
        PG8_WAIT_V(6); PG8_BAR;
    }
    for (;;) {
        const bool has_next = S.next(ui + 1, nxt);
        const char* nA = has_next ? (const char*)g.A + (size_t)nxt.pm * tstep : cA; const char* nB = has_next ? (const char*)g.Bt + (size_t)nxt.pn * tstep : cB;
        for (int t = 0; t < nt; t += 2) {
            const bool last = (t == nt - 2);
            const char* a1 = cA + (size_t)(t + 1) * kstep;
            const char* a2 = last ? nA : cA + (size_t)(t + 2) * kstep; const char* b2 = last ? nB : cB + (size_t)(t + 2) * kstep;
            const char* a3 = a2 + kstep; const char* b3 = b2 + kstep;
            if (last && has_next) S.a_ready(nxt);
            if constexpr (SP2) {
            PG8_LDB(B0, 0, 0); PG8_LDB(B1, 0, 1); PG8_SCHED; PG8_LDA(At, 0, 0); PG8_STAGE(PG8_SA(1, 1), a1 + hstep, voffA);
            PG8_WAIT_V(8); PG8_WAIT_L(0); PG8_BAR; PG8_MMA(0, 0, At, B0); PG8_MMA(0, 1, At, B1); PG8_BAR; PG8_SCHED;
            PG8_LDA(At, 0, 1); PG8_STAGE(PG8_SB(0, 0), b2, voffB); PG8_STAGE(PG8_SB(0, 1), b2 + hstep, voffB); PG8_STAGE(PG8_SA(0, 0), a2, voffA);
            PG8_WAIT_V(8); PG8_WAIT_L(0); PG8_BAR; PG8_MMA(1, 0, At, B0); PG8_MMA(1, 1, At, B1); PG8_BAR; PG8_SCHED;
            PG8_LDB(B0, 1, 0); PG8_LDB(B1, 1, 1); PG8_SCHED; PG8_LDA(At, 1, 0); PG8_STAGE(PG8_SA(0, 1), a2 + hstep, voffA);
            PG8_WAIT_V(8); PG8_WAIT_L(0); PG8_BAR; PG8_MMA(0, 0, At, B0); PG8_MMA(0, 1, At, B1); PG8_BAR; PG8_SCHED;
            PG8_LDA(At, 1, 1); PG8_STAGE(PG8_SB(1, 0), b3, voffB); PG8_STAGE(PG8_SB(1, 1), b3 + hstep, voffB); PG8_STAGE(PG8_SA(1, 0), a3, voffA);
            PG8_WAIT_V(8); PG8_WAIT_L(0); PG8_BAR; PG8_MMA(1, 0, At, B0); PG8_MMA(1, 1, At, B1); PG8_BAR; PG8_SCHED;
            } else {
            PG8_LDB(B0, 0, 0); PG8_SCHED; PG8_LDA(At, 0, 0); PG8_STAGE(PG8_SA(1, 1), a1 + hstep, voffA);
            PG8_WAIT_L(8); PG8_BAR; PG8_WAIT_L(0); PG8_MMA(0, 0, At, B0); PG8_BAR; PG8_SCHED;
            PG8_LDB(B1, 0, 1); PG8_STAGE(PG8_SB(0, 0), b2, voffB);
            PG8_BAR; PG8_WAIT_L(0); PG8_MMA(0, 1, At, B1); PG8_BAR;
            PG8_LDA(At, 0, 1); PG8_STAGE(PG8_SA(0, 0), a2, voffA);
            PG8_BAR; PG8_WAIT_L(0); PG8_MMA(1, 0, At, B0); PG8_BAR; PG8_SCHED;
            PG8_STAGE(PG8_SB(0, 1), b2 + hstep, voffB);
            PG8_WAIT_V(6); PG8_BAR; PG8_MMA(1, 1, At, B1); PG8_BAR;
            PG8_LDB(B0, 1, 0); PG8_SCHED; PG8_LDA(At, 1, 0); PG8_STAGE(PG8_SA(0, 1), a2 + hstep, voffA);
            PG8_WAIT_L(8); PG8_BAR; PG8_WAIT_L(0); PG8_MMA(0, 0, At, B0); PG8_BAR; PG8_SCHED;
            PG8_LDB(B1, 1, 1); PG8_STAGE(PG8_SB(1, 0), b3, voffB);
            PG8_BAR; PG8_WAIT_L(0); PG8_MMA(0, 1, At, B1); PG8_BAR;
            PG8_LDA(At, 1, 1); PG8_STAGE(PG8_SA(1, 0), a3, voffA);
            PG8_BAR; PG8_WAIT_L(0); PG8_MMA(1, 0, At, B0); PG8_BAR; PG8_SCHED;
            PG8_STAGE(PG8_SB(1, 1), b3 + hstep, voffB);
            PG8_WAIT_V(6); PG8_BAR; PG8_MMA(1, 1, At, B1); PG8_BAR;
            }
        }
        if constexpr (ALIGN_EPI) { if (wr == 0) PG8_BAR; }
        if constexpr (!Epi::AFTER_DRAIN) { E(acc, cur, wr, wc, fr, fq); S.done(cur); }
        if (!has_next) break;
#pragma unroll
        for (int a = 0; a < 2; ++a)
#pragma unroll
            for (int b = 0; b < 2; ++b)
#pragma unroll
                for (int m = 0; m < 4; ++m)
#pragma unroll
                    for (int n = 0; n < 2; ++n) acc[a][b][m][n] = (f32x4){0.f, 0.f, 0.f, 0.f};
        cur = nxt; cA = nA; cB = nB; ++ui;
        if constexpr (ALIGN_EPI) { if (wr == 1) PG8_BAR; }
    }
    PG8_WAIT_V(0);
    if constexpr (!ALIGN_EPI) { if (wr == 0) PG8_BAR; }
    PG8_BAR;
    if constexpr (Epi::AFTER_DRAIN) { E.fused(acc, cur, wr, wc, fr, fq, lds, wid, lane); S.done(cur); }
#undef PG8_SA
#undef PG8_SB
#undef PG8_STAGE
#undef PG8_LDA
#undef PG8_LDB
#undef PG8_MMA
#undef PG8_WAIT_V
#undef PG8_WAIT_L
#undef PG8_BAR
#undef PG8_SCHED
}
}
#define GAS __attribute__((address_space(1)))
#define LAS __attribute__((address_space(3)))
typedef unsigned short bf16;
typedef unsigned v4u __attribute__((ext_vector_type(4)));
typedef float f32x4 __attribute__((ext_vector_type(4)));
typedef short bf16x8 __attribute__((ext_vector_type(8)));
typedef GAS unsigned gu32;
typedef GAS unsigned long long gu64;
#define RLX_AGENT __ATOMIC_RELAXED, __HIP_MEMORY_SCOPE_AGENT
#define LDS_WAIT() asm volatile("s_waitcnt lgkmcnt(0)" ::: "memory")
#define VM_WAIT() asm volatile("s_waitcnt vmcnt(0)" ::: "memory")
__device__ __forceinline__ unsigned long long rt() { return __builtin_amdgcn_s_memrealtime(); }
__device__ __forceinline__ unsigned f2bf(float f) { unsigned u = __builtin_bit_cast(unsigned, f); return (u + 0x7fffu + ((u >> 16) & 1u)) >> 16; }
__device__ __forceinline__ unsigned pk2(float lo, float hi) { return f2bf(lo) | (f2bf(hi) << 16); }

#define XB_TMO      128
#define XB_XCNT(j)  (256  + 64 * (j))
#define XB_XSUB(j)  (1280 + 64 * (j))
#define XB_XGEN(j)  (2304 + 64 * (j))
#define XB_TOP      3328
#define XB_TOPGEN   3392
#define XCD_BAR_WORDS 3456
#define XB_SPIN_CAP (1u << 18)

__device__ __forceinline__ unsigned xb_ld(unsigned* p)              { return __hip_atomic_load(p, __ATOMIC_RELAXED, __HIP_MEMORY_SCOPE_AGENT); }
__device__ __forceinline__ unsigned xb_add(unsigned* p, unsigned v) { return __hip_atomic_fetch_add(p, v, __ATOMIC_RELAXED, __HIP_MEMORY_SCOPE_AGENT); }
__device__ __forceinline__ unsigned xb_xcc_id() { return (unsigned)__builtin_amdgcn_s_getreg((3 << 11) | 20) & 0xFu; }
#define XB_SPIN(cond, bar) do { unsigned _sp = 0; while (cond) { __builtin_amdgcn_s_sleep(1); \
    if ((++_sp & 255u) == 0u) { if (xb_ld(&(bar)[XB_TMO])) break; if (_sp > XB_SPIN_CAP) { atomicAdd(&(bar)[XB_TMO], 1u); break; } } } } while (0)

struct XcdBarrier {
    unsigned* bar; unsigned x;
    volatile LAS unsigned* st;
};

__device__ __forceinline__ XcdBarrier xcd_barrier_post(unsigned* bar, volatile LAS unsigned* st) {
    XcdBarrier b; b.bar = bar; b.x = xb_xcc_id(); b.st = st;
    if (threadIdx.x == 0) (void)xb_add(&bar[XB_XCNT(b.x)], 1u);
    return b;
}
__device__ __forceinline__ void xcd_barrier_complete(unsigned* bar, unsigned x, unsigned& nloc, unsigned& nx) {
    const unsigned G = gridDim.x * gridDim.y * gridDim.z;
    unsigned sum, cnt, mine, sp = 0u;
    for (;;) {
        sum = 0u; cnt = 0u; mine = 0u;
#pragma unroll
        for (unsigned j = 0; j < 16; ++j) { const unsigned c = xb_ld(&bar[XB_XCNT(j)]); sum += c; cnt += (c > 0u) ? 1u : 0u; mine = (j == x) ? c : mine; }
        if (sum == G) break;
        __builtin_amdgcn_s_sleep(1);
        if ((++sp & 255u) == 0u) { if (xb_ld(&bar[XB_TMO])) break; if (sp > XB_SPIN_CAP) { atomicAdd(&bar[XB_TMO], 1u); break; } }
    }
    nloc = mine > 0u ? mine : 1u; nx = cnt > 0u ? cnt : 1u;
}

__device__ __forceinline__ void xcd_barrier(const XcdBarrier& b) {
    asm volatile("s_waitcnt vmcnt(0)" ::: "memory");
    __syncthreads();
    if (threadIdx.x == 0) {
        unsigned* bar = b.bar;
        __builtin_amdgcn_s_waitcnt(0);
        unsigned nloc = b.st[0], nx = b.st[1];
        if (nloc == 0u) { xcd_barrier_complete(bar, b.x, nloc, nx); b.st[0] = nloc; b.st[1] = nx; }
        const unsigned old = xb_add(&bar[XB_XSUB(b.x)], 1u);
        const unsigned gen = old / nloc;
        if (old + 1u == (gen + 1u) * nloc) {
            __builtin_amdgcn_fence(__ATOMIC_RELEASE, "agent");
            asm volatile("s_waitcnt vmcnt(0)" ::: "memory");
            const unsigned og = xb_add(&bar[XB_TOP], 1u);
            const unsigned tg = og / nx;
            if (og + 1u == (tg + 1u) * nx) xb_add(&bar[XB_TOPGEN], 1u);
            else XB_SPIN(xb_ld(&bar[XB_TOPGEN]) == tg, bar);
            __builtin_amdgcn_fence(__ATOMIC_ACQUIRE, "agent");
            xb_add(&bar[XB_XGEN(b.x)], 1u);
            asm volatile("s_waitcnt vmcnt(0)" ::: "memory");
        } else {
            XB_SPIN(xb_ld(&bar[XB_XGEN(b.x)]) == gen, bar);
            __builtin_amdgcn_fence(__ATOMIC_ACQUIRE, "agent");
            asm volatile("s_waitcnt vmcnt(0)" ::: "memory");
        }
    }
    __syncthreads();
}


constexpr int NWAVES = 8;
constexpr int M = 16384, SEQ = 8192, D = 1024, DFF = 2816, MW = 3088, MP = 3072, AW = 1536;
constexpr float EPS = 1e-6f;
constexpr size_t MiB = 1u << 20;
constexpr size_t WS_CTL = 0, CTL_ZERO_BYTES = 1 * MiB;
constexpr size_t WS_PART = 1 * MiB;
constexpr size_t WS_GATES = 2 * MiB;
constexpr size_t WS_SMALL = 3 * MiB;
constexpr size_t WS_ROPE = 4 * MiB;
constexpr size_t WS_NBUF = 8 * MiB;
constexpr size_t WS_WG = 9 * MiB;
constexpr size_t WS_W = 10 * MiB;
constexpr size_t W_MIN = WS_W, W_MOUT = W_MIN + 12 * MiB, W_AIN = W_MOUT + 4 * MiB, W_AOUT = W_AIN + 6 * MiB, W_FIN = W_AOUT + 4 * MiB, W_FOUT = W_FIN + 44 * MiB;
constexpr size_t WS_XB = 102 * MiB;
constexpr size_t WS_HS = 134 * MiB;
constexpr size_t WS_PROJ = 166 * MiB;
constexpr size_t WS_KV = 262 * MiB;
constexpr size_t WS_END = 326 * MiB;
static_assert(W_FOUT + 22 * MiB == WS_XB, "weight map");
constexpr int CW_BAR = 4096;

constexpr int RING_OFF = 0, RING_BYTES = 131072;
constexpr int LDSCTL_OFF = RING_BYTES, MISC_OFF = LDSCTL_OFF + 320;
constexpr int LDS_BYTES = 147456;

using pg8::shx; using pg8::xhalf_sum; using pg8::xhalf_max;
__device__ __forceinline__ float wave_sum(float v) { v += shx<1>(v); v += shx<2>(v); v += shx<4>(v); v += shx<8>(v); v += shx<16>(v); return xhalf_sum(v); }
__device__ __forceinline__ float wave_max(float v) { v = fmaxf(v, shx<1>(v)); v = fmaxf(v, shx<2>(v)); v = fmaxf(v, shx<4>(v)); v = fmaxf(v, shx<8>(v)); v = fmaxf(v, shx<16>(v)); return xhalf_max(v); }
#define DPPF(old, src, ctrl, rm) __int_as_float(__builtin_amdgcn_update_dpp(__float_as_int(old), __float_as_int(src), ctrl, rm, 0xf, false))
__device__ __forceinline__ float wscan_add(float v) {
    v += DPPF(0.f, v, 0x111, 0xf); v += DPPF(0.f, v, 0x112, 0xf); v += DPPF(0.f, v, 0x114, 0xf); v += DPPF(0.f, v, 0x118, 0xf); v += DPPF(0.f, v, 0x142, 0xa); v += DPPF(0.f, v, 0x143, 0xc); return v; }
__device__ __forceinline__ float wscan_max(float v) {
    const float ni = -INFINITY;
    v = fmaxf(v, DPPF(ni, v, 0x111, 0xf)); v = fmaxf(v, DPPF(ni, v, 0x112, 0xf)); v = fmaxf(v, DPPF(ni, v, 0x114, 0xf)); v = fmaxf(v, DPPF(ni, v, 0x118, 0xf)); v = fmaxf(v, DPPF(ni, v, 0x142, 0xa)); v = fmaxf(v, DPPF(ni, v, 0x143, 0xc)); return v; }
__device__ __forceinline__ float wave_shr1(float v, float fill) { return DPPF(fill, v, 0x138, 0xf); }
__device__ __forceinline__ float lane63(float v) { return __int_as_float(__builtin_amdgcn_readlane(__float_as_int(v), 63)); }
__device__ __forceinline__ float bf2f(unsigned short b) { return __uint_as_float((unsigned)b << 16); }
__device__ __forceinline__ float log_sigmoidf(float x) { return fminf(x, 0.f) - log1pf(expf(-fabsf(x))); }

struct Args { const float* in[14]; float* out; unsigned char* ws; int ph_lo, ph_hi; };

struct ColMap {
    int type;
    __device__ __forceinline__ int src(int n) const {
        if (type == 2) return n < 1280 ? ((n & ~63) + ((n & 63) >> 1) + 32 * (n & 1)) : n;
        if (type == 3) { const int pn = n >> 8, r = n & 255; return r < 128 ? 128 * pn + r : DFF + 128 * pn + (r - 128); }
        return n;
    }
    __device__ __forceinline__ float scale(int n) const {
        if (type == 1) return n < 512 ? 0.08838834764831845f : 1.0f;
        if (type == 2) return n < 1024 ? 0.125f : 1.0f;
        return 1.0f;
    }
};
__device__ __forceinline__ void wt_item(const float* W, int ldn, int K, const float* nw, bf16* WT, ColMap mp, LAS float* scr, int item, int nblk, int lane) {
    const int kb = item / nblk, nb = item % nblk, k0 = 64 * kb, n0 = 32 * nb;
    const int sc = mp.src(n0 + (lane & 31)); const float s = mp.scale(n0 + (lane & 31));
#pragma unroll 8
    for (int i = 0; i < 32; ++i) { const int kk = 2 * i + (lane >> 5); float w = W[(size_t)(k0 + kk) * ldn + sc] * s; if (nw) w *= nw[k0 + kk]; scr[kk * 33 + (lane & 31)] = w; }
    LDS_WAIT(); asm volatile("" ::: "memory");
    const int c = lane & 7;
#pragma unroll
    for (int j = 0; j < 4; ++j) { const int n = (lane >> 3) + 8 * j; const LAS float* sp = scr + (8 * c) * 33 + n;
        v4u o; o.x = pk2(sp[0 * 33], sp[1 * 33]); o.y = pk2(sp[2 * 33], sp[3 * 33]); o.z = pk2(sp[4 * 33], sp[5 * 33]); o.w = pk2(sp[6 * 33], sp[7 * 33]);
        *(GAS v4u*)(WT + (size_t)(n0 + n) * K + k0 + 8 * c) = o; }
    LDS_WAIT(); asm volatile("" ::: "memory");
}

struct Ptrs {
    const float *x; const int* pos; const float *norm_mix_w, *norm_ffn_w, *norm_final_w, *mlstm_w_in, *mlstm_b_gate, *mlstm_norm_w, *mlstm_w_out, *attn_w_in, *attn_sink, *attn_w_out, *ffn_w_in, *ffn_w_out;
    float* out; unsigned char* ws;
};

__device__ __forceinline__ void p0_prologue(const Ptrs& P, LAS unsigned char* lds, int vcu, int G, int wave, int lane) {
    LAS float* scr = (LAS float*)(lds + RING_OFF + wave * 16384);
    const int gw = vcu * NWAVES + wave, NGW = G * NWAVES;
    constexpr int I_MIN = 16 * 96, I_SQ = 16 * 32, I_AIN = 16 * 48, I_FIN = 16 * 176, I_FOUT = 44 * 32;
    constexpr int NITEMS = 2 * I_MIN + 2 * I_SQ + 2 * I_AIN + 2 * I_SQ + 4 * I_FIN + 4 * I_FOUT;
    unsigned char* ws = P.ws;
    for (int it = gw; it < NITEMS; it += NGW) {
        int r = it;
        if (r < 2 * I_MIN) { const int L = r / I_MIN; r %= I_MIN; wt_item(P.mlstm_w_in + (size_t)L * D * MW, MW, D, P.norm_mix_w + (2 * L) * D, (bf16*)(ws + W_MIN) + (size_t)L * MP * D, ColMap{1}, scr, r, MP / 32, lane); continue; } r -= 2 * I_MIN;
        if (r < 2 * I_SQ) { const int L = r / I_SQ; r %= I_SQ; wt_item(P.mlstm_w_out + (size_t)L * D * D, D, D, nullptr, (bf16*)(ws + W_MOUT) + (size_t)L * D * D, ColMap{0}, scr, r, D / 32, lane); continue; } r -= 2 * I_SQ;
        if (r < 2 * I_AIN) { const int L = r / I_AIN; r %= I_AIN; wt_item(P.attn_w_in + (size_t)L * D * AW, AW, D, P.norm_mix_w + (2 * L + 1) * D, (bf16*)(ws + W_AIN) + (size_t)L * AW * D, ColMap{2}, scr, r, AW / 32, lane); continue; } r -= 2 * I_AIN;
        if (r < 2 * I_SQ) { const int L = r / I_SQ; r %= I_SQ; wt_item(P.attn_w_out + (size_t)L * D * D, D, D, nullptr, (bf16*)(ws + W_AOUT) + (size_t)L * D * D, ColMap{0}, scr, r, D / 32, lane); continue; } r -= 2 * I_SQ;
        if (r < 4 * I_FIN) { const int L = r / I_FIN; r %= I_FIN; wt_item(P.ffn_w_in + (size_t)L * D * 2 * DFF, 2 * DFF, D, P.norm_ffn_w + L * D, (bf16*)(ws + W_FIN) + (size_t)L * 2 * DFF * D, ColMap{3}, scr, r, 2 * DFF / 32, lane); continue; } r -= 4 * I_FIN;
        { const int L = r / I_FOUT; r %= I_FOUT; wt_item(P.ffn_w_out + (size_t)L * DFF * D, D, DFF, nullptr, (bf16*)(ws + W_FOUT) + (size_t)L * D * DFF, ColMap{0}, scr, r, D / 32, lane); }
    }
    float* part = (float*)(ws + WS_PART); bf16* xb = (bf16*)(ws + WS_XB);
    for (int m = gw; m < M; m += NGW) {
        const GAS f32x4* xr = (const GAS f32x4*)(P.x + (size_t)m * D) + lane;
        GAS f32x4* orow = (GAS f32x4*)(P.out + (size_t)m * D) + lane;
        GAS unsigned long long* o8 = (GAS unsigned long long*)(xb + (size_t)m * D) + lane;
        float s = 0.f;
#pragma unroll
        for (int j = 0; j < 4; ++j) { const f32x4 v = xr[64 * j]; s += (v.x * v.x + v.y * v.y) + (v.z * v.z + v.w * v.w); orow[64 * j] = v;
            o8[64 * j] = (unsigned long long)pk2(v.x, v.y) | ((unsigned long long)pk2(v.z, v.w) << 32); }
        s = wave_sum(s);
        if (lane < 16) part[(size_t)m * 16 + lane] = lane == 0 ? s : 0.f;
    }
    float* cosT = (float*)(ws + WS_ROPE); float* sinT = cosT + (size_t)M * 32;
    for (int idx = gw * 64 + lane; idx < M * 32; idx += NGW * 64) {
        const int t = idx >> 5, i = idx & 31;
        const float inv = powf(10000.0f, -(float)i / 32.0f);
        const float ang = (float)P.pos[t] * inv;
        cosT[idx] = cosf(ang); sinT[idx] = sinf(ang);
    }
    bf16* wg = (bf16*)(ws + WS_WG);
    for (int idx = gw * 64 + lane; idx < 2 * 16 * 1024; idx += NGW * 64) {
        const int L = idx >> 14, g = (idx >> 10) & 15, k = idx & 1023;
        wg[idx] = (bf16)f2bf(P.mlstm_w_in[(size_t)L * D * MW + (size_t)k * MW + 3072 + g] * P.norm_mix_w[(2 * L) * D + k]);
    }
}

typedef float f32x4v __attribute__((ext_vector_type(4)));
__device__ __forceinline__ void gates_step(const Ptrs& P, int L, LAS unsigned char* lds, int blk, int wave, int lane) {
    unsigned char* ws = P.ws;
    const bf16* xb = (const bf16*)(ws + WS_XB); const bf16* wg = (const bf16*)(ws + WS_WG) + (size_t)L * 16 * 1024;
    const float* part = (const float*)(ws + WS_PART); float* gates = (float*)(ws + WS_GATES);
    const int tg = wave & 3, kh = wave >> 2, fr = lane & 15, fq = lane >> 4;
    const int row0 = blk * 64 + tg * 16;
    f32x4v acc = {0.f, 0.f, 0.f, 0.f};
    const bf16* ap = xb + (size_t)(row0 + fr) * D + kh * 512 + fq * 8;
    const bf16* bp = wg + (size_t)fr * 1024 + kh * 512 + fq * 8;
#pragma unroll 4
    for (int s = 0; s < 16; ++s) {
        const bf16x8 a = *(const bf16x8*)(ap + s * 32), b = *(const bf16x8*)(bp + s * 32);
        acc = __builtin_amdgcn_mfma_f32_16x16x32_bf16(a, b, acc, 0, 0, 0);
    }
    LAS f32x4v* ex = (LAS f32x4v*)(lds + RING_OFF);
    if (kh == 1) ex[tg * 64 + lane] = acc;
    __syncthreads();
    if (kh == 0) {
        const f32x4v o = ex[tg * 64 + lane]; acc = acc + o;
        const int g = fr; const float bias = P.mlstm_b_gate[L * 16 + g];
#pragma unroll
        for (int r = 0; r < 4; ++r) {
            const int row = row0 + 4 * fq + r;
            float s = 0.f;
#pragma unroll
            for (int p = 0; p < 4; ++p) { const f32x4 pv = *(const f32x4*)(part + (size_t)row * 16 + 4 * p); s += (pv.x + pv.y) + (pv.z + pv.w); }
            const float rstd = rsqrtf(s * (1.0f / 1024.0f) + EPS);
            float v = acc[r] * rstd + bias;
            if (g & 4) v = log_sigmoidf(v);
            gates[(size_t)row * 16 + g] = v;
        }
    }
    __syncthreads();
}

typedef float f32x16 __attribute__((ext_vector_type(16)));
typedef short s16x4 __attribute__((ext_vector_type(4)));
typedef unsigned v2u __attribute__((ext_vector_type(2)));
constexpr int XTRA_OFF = LDSCTL_OFF + 1024;
static_assert(XTRA_OFF + 15 * 1024 <= LDS_BYTES, "LDS map");

__device__ __forceinline__ int crow(int r, int hh) { return (r & 3) + 8 * (r >> 2) + 4 * hh; }
__device__ __forceinline__ s16x4 tr_read(LAS const unsigned char* p) { return __builtin_bit_cast(s16x4, __builtin_amdgcn_ds_read_tr16_b64_v4i16((LAS s16x4*)p)); }
__device__ __forceinline__ bf16x8 cat8(s16x4 lo, s16x4 hi) { return (bf16x8){lo[0], lo[1], lo[2], lo[3], hi[0], hi[1], hi[2], hi[3]}; }
__device__ __forceinline__ unsigned cvtpk(float lo, float hi) { unsigned r; asm volatile("v_cvt_pk_bf16_f32 %0, %1, %2" : "=v"(r) : "v"(lo), "v"(hi)); return r; }

constexpr int AT_ROWS = 320, AT_K = 0, AT_V = AT_ROWS * 128, AT_WS = 2 * AT_ROWS * 128;
__device__ __forceinline__ void attn_phase(const bf16* proj, const float* sink, bf16* hs, LAS unsigned char* lds, int vcu, int G, int tid) {
    const int wave = __builtin_amdgcn_readfirstlane(tid >> 6), g = wave & 3, rb = wave >> 2;
    LAS float* wsf = (LAS float*)(lds + AT_WS) + wave * 64;
    for (int item = vcu; item < 1024; item += G) {
        int tid_i = tid; asm volatile("" : "+v"(tid_i));
        const int lane = tid_i & 63, r32 = lane & 31, hh = lane >> 5;
        const int b = item >> 9, hkv = (item >> 7) & 3, qb = item & 127, q0 = qb * 64, hq = hkv * 4 + g;
#pragma unroll
        for (int i = 0; i < 5; ++i) {
            const int idx = tid_i + 512 * i, row = idx >> 3, c = idx & 7, kp = q0 - 128 + row;
            v4u kv = {0u, 0u, 0u, 0u}, vv = {0u, 0u, 0u, 0u};
            if (kp >= 0 && kp < SEQ) { const bf16* src = proj + (size_t)(b * SEQ + kp) * AW + 1024 + hkv * 64 + c * 8; kv = *(const v4u*)src; vv = *(const v4u*)(src + 256); }
            *(LAS v4u*)(lds + AT_K + row * 128 + ((c ^ ((row >> 1) & 7)) << 4)) = kv;
            *(LAS v4u*)(lds + AT_V + row * 128 + ((c ^ (((row >> 1) & 1) << 2)) << 4)) = vv;
        }
        bf16x8 qf[4];
        { const bf16* qp = proj + (size_t)(b * SEQ + q0 + 32 * rb + r32) * AW + hq * 64 + 8 * hh;
#pragma unroll
          for (int s = 0; s < 4; ++s) qf[s] = *(const bf16x8*)(qp + 16 * s); }
        float m = sink[hq], l = hh == 0 ? 1.0f : 0.0f;
        f32x16 o[2]; o[0] = (f32x16){}; o[1] = (f32x16){};
        __syncthreads();
        const int qpos = q0 + 32 * rb + r32;
        for (int kb = 0; kb < 9; ++kb) {
            const int krow0 = 32 * rb + 32 * kb;
            f32x16 x = (f32x16){};
            { const int kr = krow0 + r32; LAS const unsigned char* kbp = lds + AT_K + kr * 128; const int sw = (kr >> 1) & 7;
#pragma unroll
              for (int s = 0; s < 4; ++s) { const bf16x8 kf = *(LAS const bf16x8*)(kbp + (((2 * s + hh) ^ sw) << 4)); x = __builtin_amdgcn_mfma_f32_32x32x16_bf16(kf, qf[s], x, 0, 0, 0); } }
            float bmax = -INFINITY;
#pragma unroll
            for (int r = 0; r < 16; ++r) { const int kp = q0 - 128 + krow0 + crow(r, hh); const int dd = qpos - kp;
                const bool ok = (kp >= 0) && (kp < SEQ) && (dd <= 128) && (dd >= -128);
                x[r] = ok ? x[r] : -INFINITY; bmax = fmaxf(bmax, x[r]); }
            bmax = xhalf_max(bmax);
            const float mn = fmaxf(m, bmax), f = __expf(m - mn);
            m = mn;
            float ps = 0.f;
#pragma unroll
            for (int r = 0; r < 16; ++r) { x[r] = __expf(x[r] - mn); ps += x[r]; }
            l = l * f + ps;
            if (hh == 0) wsf[r32] = f;
            bf16x8 pa[2];
#pragma unroll
            for (int s = 0; s < 2; ++s) { v4u w; w.x = cvtpk(x[8 * s + 0], x[8 * s + 1]); w.y = cvtpk(x[8 * s + 2], x[8 * s + 3]); w.z = cvtpk(x[8 * s + 4], x[8 * s + 5]); w.w = cvtpk(x[8 * s + 6], x[8 * s + 7]); pa[s] = __builtin_bit_cast(bf16x8, w); }
            LDS_WAIT();
#pragma unroll
            for (int r = 0; r < 16; ++r) { const float fr_ = wsf[crow(r, hh)]; o[0][r] *= fr_; o[1][r] *= fr_; }
#pragma unroll
            for (int s = 0; s < 2; ++s)
#pragma unroll
                for (int eb = 0; eb < 2; ++eb) {
                    const int R0 = krow0 + 16 * s + 4 * hh + ((lane & 15) >> 2);
                    const int ch = 4 * eb + 2 * ((lane >> 4) & 1) + ((lane & 3) >> 1);
                    const s16x4 lo = tr_read(lds + AT_V + R0 * 128 + ((ch ^ (((R0 >> 1) & 1) << 2)) << 4) + 8 * (lane & 1));
                    const int R1 = R0 + 8;
                    const s16x4 hi = tr_read(lds + AT_V + R1 * 128 + ((ch ^ (((R1 >> 1) & 1) << 2)) << 4) + 8 * (lane & 1));
                    o[eb] = __builtin_amdgcn_mfma_f32_32x32x16_bf16(pa[s], cat8(lo, hi), o[eb], 0, 0, 0);
                }
        }
        l = xhalf_sum(l);
        if (hh == 0) wsf[32 + r32] = l;
        LDS_WAIT();
        bf16* op = hs + (size_t)(b * SEQ + q0 + 32 * rb) * D + hq * 64 + r32;
#pragma unroll
        for (int r = 0; r < 16; ++r) { const int t = crow(r, hh); const float rl = 1.0f / wsf[32 + t];
            op[(size_t)t * D] = (bf16)f2bf(o[0][r] * rl); op[(size_t)t * D + 32] = (bf16)f2bf(o[1][r] * rl); }
        __syncthreads();
    }
}

__device__ __forceinline__ int qk8(int row, int g8) { return row * 256 + ((g8 ^ (row & 31)) << 3); }
__device__ __forceinline__ int vt16(int row, int c16, int rowbytes) { return row * rowbytes + ((c16 ^ ((row & 3) << 2)) << 4); }
__device__ __forceinline__ void unpack8(v4u w, float (&f)[8]) {
    f[0] = __uint_as_float(w.x << 16); f[1] = __uint_as_float(w.x & 0xffff0000u); f[2] = __uint_as_float(w.y << 16); f[3] = __uint_as_float(w.y & 0xffff0000u);
    f[4] = __uint_as_float(w.z << 16); f[5] = __uint_as_float(w.z & 0xffff0000u); f[6] = __uint_as_float(w.w << 16); f[7] = __uint_as_float(w.w & 0xffff0000u);
}
constexpr int ML_A = 0, ML_B = 32768, ML_V = 65536;

__device__ __forceinline__ void mlstm_chunk_phase(const bf16* proj, const float* gates, bf16* kvb, float* nbuf, float* blam, LAS unsigned char* lds, int vcu, int G, int tid) {
    const int wave = __builtin_amdgcn_readfirstlane(tid >> 6), db = wave & 3, eh = wave >> 2;
    LAS float* gs = (LAS float*)(lds + XTRA_OFF);
    LAS float* wv = gs + 512;
    for (int item = vcu; item < 512; item += G) {
        int tid_i = tid; asm volatile("" : "+v"(tid_i));
        const int tid = tid_i, lane = tid & 63, hh = lane >> 5;
        const int bh = item >> 6, c = item & 63, b = bh >> 2, h = bh & 3, tok0 = b * SEQ + c * 128;
        { const int s = tid & 127, which = tid >> 7; gs[which * 128 + s] = gates[(size_t)(tok0 + s) * 16 + which * 4 + h]; }
#pragma unroll
        for (int i = 0; i < 8; ++i) { const int idx = tid + 512 * i, row = idx >> 5, c16 = idx & 31;
            const v4u v = *(const v4u*)(proj + (size_t)(tok0 + row) * MP + 1024 + h * 256 + c16 * 8);
            *(LAS v4u*)(lds + ML_V + vt16(row, c16, 512)) = v; }
        __syncthreads();
        if (wave < 2) {
            const int dir = wave, s0 = dir ? 127 - 2 * lane : 2 * lane, s1 = dir ? 126 - 2 * lane : 2 * lane + 1;
            const float li0 = gs[dir * 256 + s0], lf0 = gs[dir * 256 + 128 + s0], li1 = gs[dir * 256 + s1], lf1 = gs[dir * 256 + 128 + s1];
            const float pair = lf0 + lf1, inc = wscan_add(pair), exc = inc - pair, b0 = exc + lf0, b1 = inc;
            const float bl = lane63(inc);
            const float a0 = bl - b0 + li0, a1 = bl - b1 + li1;
            const float am = wave_max(fmaxf(a0, a1));
            wv[dir * 128 + s0] = __expf(a0 - am); wv[dir * 128 + s1] = __expf(a1 - am);
            if (lane == 0) { blam[((size_t)(dir * 8 + bh) * 64 + c) * 2] = bl; blam[((size_t)(dir * 8 + bh) * 64 + c) * 2 + 1] = am; }
        }
        __syncthreads();
#pragma unroll
        for (int i = 0; i < 4; ++i) { const int idx = tid + 512 * i, row = idx >> 4, c16 = idx & 15;
            const v4u kv = *(const v4u*)(proj + (size_t)(tok0 + row) * MP + 512 + h * 128 + c16 * 8);
            float f[8]; unpack8(kv, f);
            const float w0 = wv[row], w1 = wv[128 + row];
            v4u a, bb;
            a.x = cvtpk(f[0] * w0, f[1] * w0); a.y = cvtpk(f[2] * w0, f[3] * w0); a.z = cvtpk(f[4] * w0, f[5] * w0); a.w = cvtpk(f[6] * w0, f[7] * w0);
            bb.x = cvtpk(f[0] * w1, f[1] * w1); bb.y = cvtpk(f[2] * w1, f[3] * w1); bb.z = cvtpk(f[4] * w1, f[5] * w1); bb.w = cvtpk(f[6] * w1, f[7] * w1);
            *(LAS v4u*)(lds + ML_A + vt16(row, c16, 256)) = a; *(LAS v4u*)(lds + ML_B + vt16(row, c16, 256)) = bb; }
        __syncthreads();
        if (tid < 256) {
            const int dir = tid >> 7, d = tid & 127; float s = 0.f;
            LAS const unsigned char* kb = lds + (dir ? ML_B : ML_A);
#pragma unroll 8
            for (int r = 0; r < 128; ++r) s += bf2f(*(LAS const unsigned short*)(kb + vt16(r, d >> 3, 256) + (d & 7) * 2));
            nbuf[((size_t)(dir * 8 + bh) * 64 + c) * 128 + d] = s;
        }
        f32x16 af[4], ab[4];
#pragma unroll
        for (int e = 0; e < 4; ++e) { af[e] = (f32x16){}; ab[e] = (f32x16){}; }
        const int q4 = (lane & 15) >> 2, lo8 = 8 * (lane & 1), cq = 2 * ((lane >> 4) & 1) + ((lane & 3) >> 1);
#pragma unroll 2
        for (int ks = 0; ks < 8; ++ks) {
            const int R = 16 * ks + 8 * hh + q4;
            const int cha = 4 * db + cq;
            const bf16x8 Af = cat8(tr_read(lds + ML_A + vt16(R, cha, 256) + lo8), tr_read(lds + ML_A + vt16(R + 4, cha, 256) + lo8));
            const bf16x8 Ab = cat8(tr_read(lds + ML_B + vt16(R, cha, 256) + lo8), tr_read(lds + ML_B + vt16(R + 4, cha, 256) + lo8));
#pragma unroll
            for (int eb = 0; eb < 4; ++eb) {
                const int chv = 4 * (4 * eh + eb) + cq;
                const bf16x8 Bv = cat8(tr_read(lds + ML_V + vt16(R, chv, 512) + lo8), tr_read(lds + ML_V + vt16(R + 4, chv, 512) + lo8));
                af[eb] = __builtin_amdgcn_mfma_f32_32x32x16_bf16(Af, Bv, af[eb], 0, 0, 0);
                ab[eb] = __builtin_amdgcn_mfma_f32_32x32x16_bf16(Ab, Bv, ab[eb], 0, 0, 0);
            }
        }
#pragma unroll
        for (int dir = 0; dir < 2; ++dir) {
            char* ob = (char*)(kvb + ((size_t)(dir * 8 + bh) * 64 + c) * 32768 + (size_t)(db * 8 + 4 * eh) * 1024);
            const unsigned olo = (unsigned)lane * 16u;
#pragma unroll
            for (int eb = 0; eb < 4; ++eb)
#pragma unroll
                for (int k2 = 0; k2 < 2; ++k2) {
                    const f32x16& a = dir ? ab[eb] : af[eb];
                    v4u w; w.x = cvtpk(a[8 * k2 + 0], a[8 * k2 + 1]); w.y = cvtpk(a[8 * k2 + 2], a[8 * k2 + 3]); w.z = cvtpk(a[8 * k2 + 4], a[8 * k2 + 5]); w.w = cvtpk(a[8 * k2 + 6], a[8 * k2 + 7]);
                    *(v4u*)(ob + (unsigned)((eb * 2 + k2) * 1024) + olo) = w;
                }
        }
        __syncthreads();
    }
}

__device__ __forceinline__ void mlstm_scan_phase(bf16* kvb, float* nbuf, const float* blam, float* mprev, int bx, int G, int tid) {
    for (int u = bx; u < 256; u += G) {
        const int seq = u >> 4, slab = u & 15, dir = seq >> 3;
        bf16* base = kvb + (size_t)seq * 64 * 32768 + (size_t)(slab * 512 + tid) * 4;
        const bool do_n = (slab == 0) && (tid < 128);
        float st[4] = {0.f, 0.f, 0.f, 0.f}, nst = 0.f, m = 0.f;
        for (int cc = 0; cc < 64; cc += 8) {
            v2u ld[8]; float nl[8];
#pragma unroll
            for (int k = 0; k < 8; ++k) { const int c = dir ? 63 - (cc + k) : cc + k; ld[k] = *(const v2u*)(base + (size_t)c * 32768); nl[k] = do_n ? nbuf[((size_t)seq * 64 + c) * 128 + tid] : 0.f; }
#pragma unroll
            for (int k = 0; k < 8; ++k) {
                const int c = dir ? 63 - (cc + k) : cc + k;
                const float bl = blam[((size_t)seq * 64 + c) * 2], am = blam[((size_t)seq * 64 + c) * 2 + 1];
                const float mn = fmaxf(bl + m, am), sp = __expf(bl + m - mn), sc = __expf(am - mn);
                v2u o; o.x = cvtpk(st[0], st[1]); o.y = cvtpk(st[2], st[3]);
                *(v2u*)(base + (size_t)c * 32768) = o;
                st[0] = sp * st[0] + sc * __uint_as_float(ld[k].x << 16); st[1] = sp * st[1] + sc * __uint_as_float(ld[k].x & 0xffff0000u);
                st[2] = sp * st[2] + sc * __uint_as_float(ld[k].y << 16); st[3] = sp * st[3] + sc * __uint_as_float(ld[k].y & 0xffff0000u);
                if (do_n) { nbuf[((size_t)seq * 64 + c) * 128 + tid] = nst; nst = sp * nst + sc * nl[k]; }
                if (slab == 0 && tid == 0) mprev[seq * 64 + c] = m;
                m = mn;
            }
        }
    }
}

__device__ __forceinline__ void mlstm_out_phase(const bf16* proj, const float* gates, const bf16* kvb, const float* nbuf, const float* mprev, const float* nw, bf16* hs,
                                                LAS unsigned char* lds, int vcu, int G, int tid) {
    const int wave = __builtin_amdgcn_readfirstlane(tid >> 6), tb = wave & 3, eh = wave >> 2;
    LAS float* gs = (LAS float*)(lds + XTRA_OFF);
    LAS float* ap = gs + 512; LAS float* Mx = gs + 768; LAS float* inr = gs + 1024; LAS float* cl = gs + 1280; LAS float* qnp = gs + 1536; LAS float* npv = gs + 2560;
    for (int item = vcu; item < 512; item += G) {
        int tid_i = tid; asm volatile("" : "+v"(tid_i));
        const int tid = tid_i, lane = tid & 63, r32 = lane & 31, hh = lane >> 5;
        const int bh = item >> 6, c = item & 63, b = bh >> 2, h = bh & 3, tok0 = b * SEQ + c * 128;
        { const int s = tid & 127, which = tid >> 7; gs[which * 128 + s] = gates[(size_t)(tok0 + s) * 16 + which * 4 + h]; }
        if (tid < 256) npv[tid] = nbuf[((size_t)((tid >> 7) * 8 + bh) * 64 + c) * 128 + (tid & 127)];
#pragma unroll
        for (int i = 0; i < 4; ++i) { const int idx = tid + 512 * i, row = idx >> 4, c16 = idx & 15;
            const bf16* src = proj + (size_t)(tok0 + row) * MP + h * 128 + c16 * 8;
            const v4u q = *(const v4u*)src, k = *(const v4u*)(src + 512);
            *(LAS v2u*)(lds + ML_A + qk8(row, 2 * c16)) = (v2u){q.x, q.y}; *(LAS v2u*)(lds + ML_A + qk8(row, 2 * c16 + 1)) = (v2u){q.z, q.w};
            *(LAS v2u*)(lds + ML_B + qk8(row, 2 * c16)) = (v2u){k.x, k.y}; *(LAS v2u*)(lds + ML_B + qk8(row, 2 * c16 + 1)) = (v2u){k.z, k.w}; }
#pragma unroll
        for (int i = 0; i < 8; ++i) { const int idx = tid + 512 * i, row = idx >> 5, c16 = idx & 31;
            const v4u v = *(const v4u*)(proj + (size_t)(tok0 + row) * MP + 1024 + h * 256 + c16 * 8);
            *(LAS v4u*)(lds + ML_V + vt16(row, c16, 512)) = v; }
        __syncthreads();
        if (wave < 2) {
            const int dir = wave, s0 = dir ? 127 - 2 * lane : 2 * lane, s1 = dir ? 126 - 2 * lane : 2 * lane + 1;
            const float li0 = gs[dir * 256 + s0], lf0 = gs[dir * 256 + 128 + s0], li1 = gs[dir * 256 + s1], lf1 = gs[dir * 256 + 128 + s1];
            const float pair = lf0 + lf1, inc = wscan_add(pair), exc = inc - pair, b0 = exc + lf0, b1 = inc;
            const float ap0 = li0 - b0, ap1 = li1 - b1;
            const float incm = wscan_max(fmaxf(ap0, ap1));
            const float excm = wave_shr1(incm, -INFINITY);
            const float pm0 = fmaxf(excm, ap0), pm1 = incm;
            const float mp = mprev[(dir * 8 + bh) * 64 + c];
            const float M0 = fmaxf(mp, pm0), M1 = fmaxf(mp, pm1);
            ap[dir * 128 + s0] = ap0; ap[dir * 128 + s1] = ap1;
            Mx[dir * 128 + s0] = M0; Mx[dir * 128 + s1] = M1;
            inr[dir * 128 + s0] = __expf(mp - M0); inr[dir * 128 + s1] = __expf(mp - M1);
            cl[dir * 128 + s0] = __expf(-(b0 + M0)); cl[dir * 128 + s1] = __expf(-(b1 + M1));
        }
        {
            const int t = tid & 127, qt = tid >> 7; float s0 = 0.f, s1 = 0.f;
#pragma unroll
            for (int g8 = 0; g8 < 8; ++g8) {
                const v2u w = *(LAS const v2u*)(lds + ML_A + qk8(t, 8 * qt + g8));
                const int d = 32 * qt + 4 * g8;
                const float q0 = __uint_as_float(w.x << 16), q1 = __uint_as_float(w.x & 0xffff0000u), q2 = __uint_as_float(w.y << 16), q3 = __uint_as_float(w.y & 0xffff0000u);
                s0 += q0 * npv[d] + q1 * npv[d + 1] + q2 * npv[d + 2] + q3 * npv[d + 3];
                s1 += q0 * npv[128 + d] + q1 * npv[128 + d + 1] + q2 * npv[128 + d + 2] + q3 * npv[128 + d + 3];
            }
            qnp[(qt * 2 + 0) * 128 + t] = s0; qnp[(qt * 2 + 1) * 128 + t] = s1;
        }
        __syncthreads();
        bf16x8 qf[8];
#pragma unroll
        for (int ks = 0; ks < 8; ++ks) {
            const v2u lo = *(LAS const v2u*)(lds + ML_A + qk8(32 * tb + r32, 4 * ks + hh)), hi = *(LAS const v2u*)(lds + ML_A + qk8(32 * tb + r32, 4 * ks + 2 + hh));
            qf[ks] = __builtin_bit_cast(bf16x8, (v4u){lo.x, lo.y, hi.x, hi.y});
        }
        const int q4 = (lane & 15) >> 2, lo8 = 8 * (lane & 1), cq = 2 * ((lane >> 4) & 1) + ((lane & 3) >> 1);
        const int tl = 32 * tb + r32;
        bf16x8 pa[5][2]; float rs0 = 0.f, rs1 = 0.f;
#pragma unroll
        for (int i = 0; i < 5; ++i) {
            const int dir = (i > tb) ? 1 : 0, sb = i - dir;
            f32x16 x = (f32x16){};
#pragma unroll
            for (int ks = 0; ks < 8; ++ks) {
                const v2u lo = *(LAS const v2u*)(lds + ML_B + qk8(32 * sb + r32, 4 * ks + hh)), hi = *(LAS const v2u*)(lds + ML_B + qk8(32 * sb + r32, 4 * ks + 2 + hh));
                x = __builtin_amdgcn_mfma_f32_32x32x16_bf16(__builtin_bit_cast(bf16x8, (v4u){lo.x, lo.y, hi.x, hi.y}), qf[ks], x, 0, 0, 0);
            }
            const float Mt = Mx[dir * 128 + tl];
            float rsum = 0.f;
#pragma unroll
            for (int r = 0; r < 16; ++r) {
                const int sl = 32 * sb + crow(r, hh);
                const bool ok = dir ? (sl >= tl) : (sl <= tl);
                const float p = ok ? x[r] * __expf(ap[dir * 128 + sl] - Mt) : 0.f;
                x[r] = p; rsum += p;
            }
            if (dir) rs1 += rsum; else rs0 += rsum;
#pragma unroll
            for (int s2 = 0; s2 < 2; ++s2) { v4u w; w.x = cvtpk(x[8 * s2 + 0], x[8 * s2 + 1]); w.y = cvtpk(x[8 * s2 + 2], x[8 * s2 + 3]); w.z = cvtpk(x[8 * s2 + 4], x[8 * s2 + 5]); w.w = cvtpk(x[8 * s2 + 6], x[8 * s2 + 7]); pa[i][s2] = __builtin_bit_cast(bf16x8, w); }
        }
        rs0 = xhalf_sum(rs0); rs1 = xhalf_sum(rs1);
        float rd0, rd1, qs0, qs1;
        { const float qn0 = (qnp[0 * 128 + tl] + qnp[2 * 128 + tl]) + (qnp[4 * 128 + tl] + qnp[6 * 128 + tl]);
          const float qn1 = (qnp[1 * 128 + tl] + qnp[3 * 128 + tl]) + (qnp[5 * 128 + tl] + qnp[7 * 128 + tl]);
          const float in0 = inr[tl], in1 = inr[128 + tl];
          rd0 = 1.0f / fmaxf(fabsf(rs0 + in0 * qn0), cl[tl]); rd1 = 1.0f / fmaxf(fabsf(rs1 + in1 * qn1), cl[128 + tl]);
          qs0 = in0 * rd0; qs1 = in1 * rd1; }
#pragma unroll
        for (int i = 0; i < 5; ++i) {
            const float rd = (i > tb) ? rd1 : rd0;
#pragma unroll
            for (int s2 = 0; s2 < 2; ++s2) { float f[8]; unpack8(__builtin_bit_cast(v4u, pa[i][s2]), f);
                v4u w; w.x = cvtpk(f[0] * rd, f[1] * rd); w.y = cvtpk(f[2] * rd, f[3] * rd); w.z = cvtpk(f[4] * rd, f[5] * rd); w.w = cvtpk(f[6] * rd, f[7] * rd); pa[i][s2] = __builtin_bit_cast(bf16x8, w); }
        }
        f32x16 acc[4];
#pragma unroll
        for (int e = 0; e < 4; ++e) acc[e] = (f32x16){};
#pragma unroll
        for (int dir = 0; dir < 2; ++dir) {
            const char* cb = (const char*)(kvb + ((size_t)(dir * 8 + bh) * 64 + c) * 32768 + (size_t)eh * 4096);
            const unsigned clo = (unsigned)lane * 16u;
            const float qsc = dir ? qs1 : qs0;
            bf16x8 cf[3][4];
#define ML_LOADC(ks_, dst) _Pragma("unroll") for (int eb = 0; eb < 4; ++eb) dst[eb] = *(const bf16x8*)(cb + (unsigned)(((((ks_) >> 1) * 8 + eb) * 2 + ((ks_) & 1)) * 1024) + clo)
            ML_LOADC(0, cf[0]); ML_LOADC(1, cf[1]);
#pragma unroll
            for (int ks = 0; ks < 8; ++ks) {
                if (ks + 2 < 8) { ML_LOADC(ks + 2, cf[(ks + 2) % 3]); }
                float f[8]; unpack8(__builtin_bit_cast(v4u, qf[ks]), f);
                v4u w; w.x = cvtpk(f[0] * qsc, f[1] * qsc); w.y = cvtpk(f[2] * qsc, f[3] * qsc); w.z = cvtpk(f[4] * qsc, f[5] * qsc); w.w = cvtpk(f[6] * qsc, f[7] * qsc);
                const bf16x8 qsv = __builtin_bit_cast(bf16x8, w);
                __builtin_amdgcn_sched_barrier(0);
#pragma unroll
                for (int eb = 0; eb < 4; ++eb) acc[eb] = __builtin_amdgcn_mfma_f32_32x32x16_bf16(qsv, cf[ks % 3][eb], acc[eb], 0, 0, 0);
                __builtin_amdgcn_sched_barrier(0);
            }
#undef ML_LOADC
        }
#pragma unroll
        for (int i = 0; i < 5; ++i) {
            const int sb = i - ((i > tb) ? 1 : 0);
#pragma unroll
            for (int s2 = 0; s2 < 2; ++s2)
#pragma unroll
                for (int eb = 0; eb < 4; ++eb) {
                    const int R0 = 32 * sb + 16 * s2 + 4 * hh + q4, chv = 4 * (4 * eh + eb) + cq;
                    const bf16x8 vf = cat8(tr_read(lds + ML_V + vt16(R0, chv, 512) + lo8), tr_read(lds + ML_V + vt16(R0 + 8, chv, 512) + lo8));
                    acc[eb] = __builtin_amdgcn_mfma_f32_32x32x16_bf16(pa[i][s2], vf, acc[eb], 0, 0, 0);
                }
        }
        __syncthreads();
#pragma unroll
        for (int e = 0; e < 4; ++e)
#pragma unroll
            for (int r = 0; r < 16; ++r) *(LAS float*)(lds + (32 * tb + crow(r, hh)) * 1024 + (128 * eh + 32 * e + r32) * 4) = acc[e][r];
        __syncthreads();
#pragma unroll 4
        for (int rr = 0; rr < 16; ++rr) {
            const int t = 16 * wave + rr;
            const f32x4 v = *(LAS const f32x4*)(lds + t * 1024 + lane * 16);
            const float ss = wave_sum((v.x * v.x + v.y * v.y) + (v.z * v.z + v.w * v.w));
            const float rn = rsqrtf(ss * (1.0f / 256.0f) + EPS);
            const v2u og = *(const v2u*)(proj + (size_t)(tok0 + t) * MP + 2048 + h * 256 + lane * 4);
            const f32x4 w4 = *(const f32x4*)(nw + h * 256 + lane * 4);
            const float o0 = __uint_as_float(og.x << 16), o1 = __uint_as_float(og.x & 0xffff0000u), o2 = __uint_as_float(og.y << 16), o3 = __uint_as_float(og.y & 0xffff0000u);
            v2u out;
            out.x = cvtpk(v.x * rn * w4.x / (1.0f + __expf(-o0)), v.y * rn * w4.y / (1.0f + __expf(-o1)));
            out.y = cvtpk(v.z * rn * w4.z / (1.0f + __expf(-o2)), v.w * rn * w4.w / (1.0f + __expf(-o3)));
            *(v2u*)(hs + (size_t)(tok0 + t) * D + h * 256 + lane * 4) = out;
        }
        __syncthreads();
    }
}

#ifndef OPT_ATTN
#define OPT_ATTN 1
#endif
#ifndef OPT_MLSTM
#define OPT_MLSTM 1
#endif
#ifndef ONE_LAUNCH
#define ONE_LAUNCH 1
#endif
__global__ void __launch_bounds__(NWAVES * 64, 2) mk_fwd(Args args) {
    extern __shared__ __attribute__((aligned(16))) unsigned char lds_raw[];
    LAS unsigned char* lds = (LAS unsigned char*)lds_raw;
    volatile LAS unsigned* MISC = (volatile LAS unsigned*)(lds + MISC_OFF);
    const int tid = threadIdx.x; const int wave_s = __builtin_amdgcn_readfirstlane(tid >> 6);
    const int G = gridDim.x; const int bx = blockIdx.x; const int vcu = (G % 8 == 0) ? (bx % 8) * (G / 8) + bx / 8 : bx;
    Ptrs P;
    P.x = args.in[0]; P.pos = (const int*)args.in[1]; P.norm_mix_w = args.in[2]; P.norm_ffn_w = args.in[3]; P.norm_final_w = args.in[4]; P.mlstm_w_in = args.in[5];
    P.mlstm_b_gate = args.in[6]; P.mlstm_norm_w = args.in[7]; P.mlstm_w_out = args.in[8]; P.attn_w_in = args.in[9]; P.attn_sink = args.in[10]; P.attn_w_out = args.in[11];
    P.ffn_w_in = args.in[12]; P.ffn_w_out = args.in[13]; P.out = args.out; P.ws = args.ws;
    unsigned char* ws = args.ws;
    gu32* ctl = (gu32*)(ws + WS_CTL);
    for (int u = tid; u < (LDS_BYTES - LDSCTL_OFF) / 4; u += NWAVES * 64) ((LAS unsigned*)(lds + LDSCTL_OFF))[u] = 0u;
    __syncthreads();
    const int lo = args.ph_lo, hi = args.ph_hi;
    XcdBarrier bar; bar.bar = (unsigned*)(ctl + CW_BAR); bar.x = 0; bar.st = nullptr;
    if (hi - lo > 1) bar = xcd_barrier_post((unsigned*)(ctl + CW_BAR), MISC + 8);
    int ph = 0;
#define PH_ON (ph >= lo && ph < hi)
#define PH_IDS int tid_p; asm volatile("v_mbcnt_lo_u32_b32 %0, -1, 0\n\tv_mbcnt_hi_u32_b32 %0, -1, %0" : "=v"(tid_p)); tid_p += wave_s * 64; asm volatile("" : "+v"(tid_p)); const int lane = tid_p & 63, wave = __builtin_amdgcn_readfirstlane(tid_p >> 6); (void)lane; (void)wave
#define PH_END do { if (ph >= lo && ph + 1 < hi) xcd_barrier(bar); ++ph; } while (0)

    bf16* xb = (bf16*)(ws + WS_XB); bf16* hs = (bf16*)(ws + WS_HS); bf16* proj = (bf16*)(ws + WS_PROJ);
    float* part = (float*)(ws + WS_PART);
    const float* cosT = (const float*)(ws + WS_ROPE); const float* sinT = cosT + (size_t)M * 32;

    if (PH_ON) { PH_IDS; p0_prologue(P, lds, vcu, G, wave, lane); }
    PH_END;

    for (int L = 0; L < 4; ++L) {
        const int j = L >> 1;
        if ((L & 1) == 0) {
            if (PH_ON) {
                { PH_IDS; for (int gb = bx; gb < M / 64; gb += G) gates_step(P, j, lds, gb, wave, lane); }
                pg8::Gemm g{xb, (const bf16*)(ws + W_MIN) + (size_t)j * MP * D, M, MP, D}; pg8::StaticOrder S; S.init(M, MP, G, bx);
                pg8::EpiProj<false> E{proj, MP, part, nullptr, nullptr};
                pg8::gemm_phase<pg8::EpiProj<false>, pg8::StaticOrder, true, true>(lds + RING_OFF, g, S, E, wave_s);
            }
            PH_END;
            if (PH_ON) { PH_IDS; mlstm_chunk_phase(proj, (const float*)(ws + WS_GATES), (bf16*)(ws + WS_KV), (float*)(ws + WS_NBUF), (float*)(ws + WS_SMALL), lds, vcu, G, tid_p); }
            PH_END;
            if (PH_ON) { PH_IDS; mlstm_scan_phase((bf16*)(ws + WS_KV), (float*)(ws + WS_NBUF), (const float*)(ws + WS_SMALL), (float*)(ws + WS_SMALL + 16384), bx, G, tid_p); }
            PH_END;
            if (PH_ON) { PH_IDS; mlstm_out_phase(proj, (const float*)(ws + WS_GATES), (const bf16*)(ws + WS_KV), (const float*)(ws + WS_NBUF), (const float*)(ws + WS_SMALL + 16384), P.mlstm_norm_w + j * D, hs, lds, vcu, G, tid_p); }
            PH_END;
        } else {
            if (PH_ON) {
                pg8::Gemm g{xb, (const bf16*)(ws + W_AIN) + (size_t)j * AW * D, M, AW, D}; pg8::StaticOrder S; S.init(M, AW, G, bx);
                pg8::EpiProj<true> E{proj, AW, part, cosT, sinT};
                pg8::gemm_phase<pg8::EpiProj<true>, pg8::StaticOrder, true, true>(lds + RING_OFF, g, S, E, wave_s);
            }
            PH_END;
            if (PH_ON) { PH_IDS; attn_phase(proj, P.attn_sink + j * 16, hs, lds, vcu, G, tid_p); }
            PH_END;
        }
        if (PH_ON) {
            const bf16* wo = (L & 1) ? (const bf16*)(ws + W_AOUT) + (size_t)j * D * D : (const bf16*)(ws + W_MOUT) + (size_t)j * D * D;
            pg8::Gemm g{hs, wo, M, D, D}; pg8::StaticOrder S; S.init(M, D, G, bx);
            pg8::EpiResid E{P.out, xb, part};
            pg8::gemm_phase<pg8::EpiResid, pg8::StaticOrder, true, true>(lds + RING_OFF, g, S, E, wave_s);
        }
        PH_END;
        if (PH_ON) {
            pg8::Gemm g{xb, (const bf16*)(ws + W_FIN) + (size_t)L * 2 * DFF * D, M, 2 * DFF, D}; pg8::StaticOrder S; S.init(M, 2 * DFF, G, bx);
            pg8::EpiSwiGLU E{proj, DFF, part};
            pg8::gemm_phase<pg8::EpiSwiGLU, pg8::StaticOrder, true, true>(lds + RING_OFF, g, S, E, wave_s);
        }
        PH_END;
        if (PH_ON) {
            pg8::Gemm g{proj, (const bf16*)(ws + W_FOUT) + (size_t)L * D * DFF, M, D, DFF}; pg8::StaticOrder S; S.init(M, D, G, bx);
            pg8::EpiResid E{P.out, xb, part};
            pg8::gemm_phase<pg8::EpiResid, pg8::StaticOrder, true, true>(lds + RING_OFF, g, S, E, wave_s);
        }
        PH_END;
    }
    if (PH_ON) {
        PH_IDS;
        const int gw = vcu * NWAVES + wave, NGW = G * NWAVES;
        for (int m = gw; m < M; m += NGW) {
            float s = lane < 16 ? part[(size_t)m * 16 + lane] : 0.f;
            s = wave_sum(s);
            const float rstd = rsqrtf(s * (1.0f / 1024.0f) + EPS);
            GAS f32x4* orow = (GAS f32x4*)(P.out + (size_t)m * D) + lane;
            const GAS f32x4* wr = (const GAS f32x4*)P.norm_final_w + lane;
#pragma unroll
            for (int jj = 0; jj < 4; ++jj) { f32x4 v = orow[64 * jj]; const f32x4 w = wr[64 * jj]; v = v * rstd * w; orow[64 * jj] = v; }
        }
    }
    PH_END;
}

namespace nv {
constexpr int TCH = 32;
__global__ void __launch_bounds__(272) k_mlstm_rec(const bf16* __restrict__ proj, const float* __restrict__ gates, bf16* __restrict__ hf, bf16* __restrict__ hb) {
    __shared__ float sq[TCH][128], sk[TCH][128], sv[TCH][17], sli[TCH], slf[TCH];
    __shared__ float red[2][16][17];
    const int es = blockIdx.x, h = blockIdx.y, b = blockIdx.z >> 1, dir = blockIdx.z & 1;
    const int tid = threadIdx.x, e = tid % 17, dg = tid / 17;
    float C[8];
#pragma unroll
    for (int j = 0; j < 8; ++j) C[j] = 0.f;
    float m = 0.f;
    bf16* hout = dir ? hb : hf;
    int par = 0;
    for (int c0 = 0; c0 < SEQ; c0 += TCH) {
        __syncthreads();
        for (int i = tid; i < TCH * 128; i += 272) {
            const int tt = i >> 7, d = i & 127;
            const int t = dir ? (SEQ - 1 - (c0 + tt)) : (c0 + tt);
            const bf16* row = proj + (size_t)(b * SEQ + t) * MP;
            sq[tt][d] = bf2f(row[h * 128 + d]);
            sk[tt][d] = bf2f(row[512 + h * 128 + d]);
        }
        for (int i = tid; i < TCH * 17; i += 272) {
            const int tt = i / 17, ee = i % 17;
            const int t = dir ? (SEQ - 1 - (c0 + tt)) : (c0 + tt);
            const bf16* row = proj + (size_t)(b * SEQ + t) * MP;
            sv[tt][ee] = ee < 16 ? bf2f(row[1024 + h * 256 + es * 16 + ee]) : 1.0f;
        }
        if (tid < TCH) {
            const int t = dir ? (SEQ - 1 - (c0 + tid)) : (c0 + tid);
            const float* row = gates + (size_t)(b * SEQ + t) * 16;
            sli[tid] = row[(dir ? 8 : 0) + h];
            slf[tid] = row[(dir ? 12 : 4) + h];
        }
        __syncthreads();
        for (int tt = 0; tt < TCH; ++tt) {
            const float li = sli[tt], lf = slf[tt];
            const float mn = fmaxf(lf + m, li);
            const float fs = expf(lf + m - mn), is = expf(li - mn);
            m = mn;
            const float vv = sv[tt][e] * is;
            float partv = 0.f;
#pragma unroll
            for (int j = 0; j < 8; ++j) {
                const int d = dg * 8 + j;
                C[j] = fs * C[j] + sk[tt][d] * vv;
                partv += sq[tt][d] * C[j];
            }
            red[par][dg][e] = partv;
            __syncthreads();
            if (tid < 16) {
                float num = 0.f, qn = 0.f;
#pragma unroll
                for (int g = 0; g < 16; ++g) { num += red[par][g][tid]; qn += red[par][g][16]; }
                const float den = fmaxf(fabsf(qn), expf(-m));
                const int t = dir ? (SEQ - 1 - (c0 + tt)) : (c0 + tt);
                hout[(size_t)(b * SEQ + t) * D + h * 256 + es * 16 + tid] = (bf16)f2bf(num / den);
            }
            par ^= 1;
        }
    }
}
__global__ void k_mlstm_post(const bf16* __restrict__ hf, const bf16* __restrict__ hb, const bf16* __restrict__ proj, const float* __restrict__ nw, bf16* __restrict__ out) {
    const int row = blockIdx.x, tid = threadIdx.x, h = tid >> 6, lane = tid & 63;
    const size_t off = (size_t)row * D + h * 256 + lane * 4;
    float v[4]; float s = 0.f;
#pragma unroll
    for (int c = 0; c < 4; ++c) { v[c] = bf2f(hf[off + c]) + bf2f(hb[off + c]); s += v[c] * v[c]; }
    for (int o = 32; o > 0; o >>= 1) s += __shfl_xor(s, o);
    const float r = rsqrtf(s * (1.0f / 256.0f) + EPS);
#pragma unroll
    for (int c = 0; c < 4; ++c) {
        const float og = bf2f(proj[(size_t)row * MP + 2048 + h * 256 + lane * 4 + c]);
        out[off + c] = (bf16)f2bf(v[c] * r * nw[h * 256 + lane * 4 + c] / (1.0f + expf(-og)));
    }
}
__global__ void __launch_bounds__(64) k_attn(const bf16* __restrict__ proj, const float* __restrict__ sink, bf16* __restrict__ out) {
    const int idx = blockIdx.x * 64 + threadIdx.x;
    const int hq = idx / M, tok = idx % M;
    const int b = tok / SEQ, i = tok % SEQ, hkv = hq >> 2;
    float q[64], acc[64];
    const bf16* qp = proj + (size_t)tok * AW + hq * 64;
#pragma unroll
    for (int d = 0; d < 64; ++d) { q[d] = bf2f(qp[d]); acc[d] = 0.f; }
    float m = sink[hq], l = 1.0f;
    const int j0 = max(0, i - 128), j1 = min(SEQ - 1, i + 128);
    for (int jx = j0; jx <= j1; ++jx) {
        const bf16* kp = proj + (size_t)(b * SEQ + jx) * AW + 1024 + hkv * 64;
        const bf16* vp = kp + 256;
        float s = 0.f;
#pragma unroll
        for (int d = 0; d < 64; ++d) s += q[d] * bf2f(kp[d]);
        if (s > m) {
            const float f = expf(m - s);
            l *= f;
#pragma unroll
            for (int d = 0; d < 64; ++d) acc[d] *= f;
            m = s;
        }
        const float p = expf(s - m);
        l += p;
#pragma unroll
        for (int d = 0; d < 64; ++d) acc[d] += p * bf2f(vp[d]);
    }
    const float rl = 1.0f / l;
    bf16* op = out + (size_t)tok * D + hq * 64;
#pragma unroll
    for (int d = 0; d < 64; ++d) op[d] = (bf16)f2bf(acc[d] * rl);
}
}

extern "C" void kernel_launch(void* const* d_in, const int* in_sizes, int n_in, void* d_out, int out_size, void* d_ws, size_t ws_size, hipStream_t stream) {
    static int grid = 0;
    if (grid == 0) {
        int dev = 0, cus = 0;
        if (hipGetDevice(&dev) != hipSuccess || hipDeviceGetAttribute(&cus, hipDeviceAttributeMultiprocessorCount, dev) != hipSuccess) { fprintf(stderr, "kernel_launch: device query failed\n"); grid = -1; return; }
        if (hipFuncSetAttribute((const void*)mk_fwd, hipFuncAttributeMaxDynamicSharedMemorySize, LDS_BYTES) != hipSuccess) { fprintf(stderr, "kernel_launch: hipFuncSetAttribute failed\n"); grid = -1; return; }
        if (ws_size < WS_END) { fprintf(stderr, "kernel_launch: workspace too small: %zu < %zu\n", ws_size, (size_t)WS_END); grid = -1; return; }
        (void)hipGetLastError();
        grid = cus;
    }
    if (grid < 0) return;
    (void)hipMemsetAsync((char*)d_ws + WS_CTL, 0, CTL_ZERO_BYTES, stream);
    Args a{};
    for (int i = 0; i < 14; ++i) a.in[i] = (const float*)d_in[i];
    a.out = (float*)d_out; a.ws = (unsigned char*)d_ws;
    unsigned char* ws = (unsigned char*)d_ws;
    int ph = 0;
    auto launch = [&](int lo, int hi) { a.ph_lo = lo; a.ph_hi = hi; hipLaunchKernelGGL(mk_fwd, dim3(grid), dim3(NWAVES * 64), LDS_BYTES, stream, a); };
#if ONE_LAUNCH
    launch(0, 1000);
#else
    launch(ph, ph + 1); ++ph;
    for (int L = 0; L < 4; ++L) {
        const int j = L >> 1;
        launch(ph, ph + 1); ++ph;
        if ((L & 1) == 0) {
#if OPT_MLSTM
            launch(ph, ph + 1); launch(ph + 1, ph + 2); launch(ph + 2, ph + 3);
#else
            bf16* hf = (bf16*)(ws + WS_KV); bf16* hb = hf + (size_t)M * D;
            hipLaunchKernelGGL(nv::k_mlstm_rec, dim3(16, 4, 4), dim3(272), 0, stream, (const bf16*)(ws + WS_PROJ), (const float*)(ws + WS_GATES), hf, hb);
            hipLaunchKernelGGL(nv::k_mlstm_post, dim3(M), dim3(256), 0, stream, (const bf16*)hf, (const bf16*)hb, (const bf16*)(ws + WS_PROJ), (const float*)d_in[7] + j * D, (bf16*)(ws + WS_HS));
#endif
            ph += 3;
        } else {
#if OPT_ATTN
            launch(ph, ph + 1);
#else
            hipLaunchKernelGGL(nv::k_attn, dim3(M * 16 / 64), dim3(64), 0, stream, (const bf16*)(ws + WS_PROJ), (const float*)d_in[10] + j * 16, (bf16*)(ws + WS_HS));
#endif
            ph += 1;
        }
        launch(ph, ph + 1); ++ph;
        launch(ph, ph + 1); ++ph;
        launch(ph, ph + 1); ++ph;
    }
    launch(ph, ph + 1); ++ph;
#endif
}
```

```cpp
#include <hip/hip_runtime.h>
#include <cstdio>
#include <cstdint>
#include <cmath>
namespace pg8 {
#define PG8_LAS __attribute__((address_space(3)))
typedef unsigned short bf16_t;
typedef short bf16x8 __attribute__((ext_vector_type(8)));
typedef float f32x4 __attribute__((ext_vector_type(4)));
typedef unsigned u32x4 __attribute__((ext_vector_type(4)));
constexpr int BM = 256, BK = 64, HALF = 128, HTB = HALF * BK * 2  , STAGE_BYTES = 8 * HTB, NXCD = 8, WGM = 8;

__host__ __device__ __forceinline__ int lds_byte(int r, int c) { const int st = (r >> 4) * 2 + (c >> 5), rr = r & 15, cc = c & 31, ob = rr * 64 + cc * 2; return st * 1024 + (ob ^ (((ob >> 9) & 1) << 5)); }
__host__ __device__ __forceinline__ void stage_rc(int b, int& R, int& C) { const int st = b / 1024, sb = b % 1024, swz = sb ^ (((sb >> 9) & 1) << 5); R = (st >> 1) * 16 + swz / 64; C = (st & 1) * 32 + (swz % 64) / 2; }
__host__ __device__ __forceinline__ int perm32(int rho) { const int n = rho >> 4, i = rho & 15; return 8 * (i >> 2) + 4 * n + (i & 3); }

struct Unit { int pm, pn; };
struct Gemm { const bf16_t* A; const bf16_t* Bt; int M, N, K; };

struct StaticOrder {
    int nM, nN, nwg, G, c;
    __host__ __device__ void init(int M, int N, int G_, int c_) { nM = M / BM; nN = N / BM; nwg = nM * nN; G = G_; c = c_; }
    __host__ __device__ bool next(int i, Unit& u) const {
        const long L = (long)i * G + c; if (L >= nwg) return false;
        int wgid = (int)L; { const int q = nwg / NXCD, r = nwg % NXCD, xcd = wgid % NXCD, off = wgid / NXCD; wgid = (xcd < r ? xcd * (q + 1) : r * (q + 1) + (xcd - r) * q) + off; }
        const int nig = WGM * nN, gid = wgid / nig, fm = gid * WGM, gsz = (nM - fm) < WGM ? (nM - fm) : WGM;
        u.pm = fm + ((wgid % nig) % gsz); u.pn = (wgid % nig) / gsz; return true;
    }
    __device__ __forceinline__ void a_ready(const Unit&) const {}
    __device__ __forceinline__ void done(const Unit&) const {}
};

__device__ __forceinline__ unsigned cvt_pk_bf16(float lo, float hi) { unsigned r; asm volatile("v_cvt_pk_bf16_f32 %0, %1, %2" : "=v"(r) : "v"(lo), "v"(hi)); return r; }
typedef float f32x2 __attribute__((ext_vector_type(2)));

constexpr int EP_M = 16384;
constexpr float EP_EPS = 1e-6f;
typedef unsigned u32x2 __attribute__((ext_vector_type(2)));

template <int K> __device__ __forceinline__ float shx(float v) { static_assert(K == 1 || K == 2 || K == 4 || K == 8 || K == 16, "xor mask"); return __int_as_float(__builtin_amdgcn_ds_swizzle(__float_as_int(v), 0x1F | (K << 10))); }
__device__ __forceinline__ float xhalf_sum(float v) { auto rr = __builtin_amdgcn_permlane32_swap(__float_as_uint(v), __float_as_uint(v), false, false); return __uint_as_float(rr[0]) + __uint_as_float(rr[1]); }
__device__ __forceinline__ float xhalf_max(float v) { auto rr = __builtin_amdgcn_permlane32_swap(__float_as_uint(v), __float_as_uint(v), false, false); return fmaxf(__uint_as_float(rr[0]), __uint_as_float(rr[1])); }
__device__ __forceinline__ void row_rstd(const float* part, int row0  , int fq, float (&rs)[2][4]) {
#pragma unroll
    for (int ai = 0; ai < 2; ++ai)
#pragma unroll
        for (int m = 0; m < 4; ++m) {
            const unsigned row = (unsigned)(row0 + ai * HALF + m * 16);
            const f32x4 pv = *(const f32x4*)((const char*)part + (row * 64u + (unsigned)fq * 16u));
            float s = (pv[0] + pv[1]) + (pv[2] + pv[3]);
            s += shx<16>(s); s = xhalf_sum(s);
            rs[ai][m] = rsqrtf(s * (1.0f / 1024.0f) + EP_EPS);
        }
}
template <bool ROPE> struct EpiProj {
    static constexpr bool PERM = true, AFTER_DRAIN = false;
    bf16_t* O; int ldc; const float* part; const float* cosT; const float* sinT;
    __device__ __forceinline__ void operator()(const f32x4 (&acc)[2][2][4][2], const Unit& u, int wr, int wc, int fr, int fq) const {
        const int row0 = u.pm * BM + wr * 64 + fr;
        float rs[2][4]; row_rstd(part, row0, fq, rs);
        const int col0 = u.pn * BM + wc * 32 + 8 * fq;
        const int i0 = (wc & 1) * 16 + 4 * fq;
        const bool rope = ROPE && (u.pn < 5);
#pragma unroll
        for (int ai = 0; ai < 2; ++ai)
#pragma unroll
            for (int m = 0; m < 4; ++m) {
                const int row = row0 + ai * HALF + m * 16;
                bf16_t* rowp = (bf16_t*)((char*)O + ((unsigned)row * (unsigned)ldc + (unsigned)col0) * 2u);
                const float r = rs[ai][m];
                f32x4 cs = {1.f, 1.f, 1.f, 1.f}, sn = {0.f, 0.f, 0.f, 0.f};
                if (rope) { const unsigned to = ((unsigned)row * 32u + (unsigned)i0) * 4u; cs = *(const f32x4*)((const char*)cosT + to); sn = *(const f32x4*)((const char*)sinT + to); }
#pragma unroll
                for (int bj = 0; bj < 2; ++bj) {
                    f32x4 v0 = acc[ai][bj][m][0] * r, v1 = acc[ai][bj][m][1] * r;
                    if (ROPE) {
                        const f32x4 a = v0, b = v1;
                        v0[0] = a[0] * cs[0] - a[1] * sn[0]; v0[1] = a[1] * cs[0] + a[0] * sn[0];
                        v0[2] = a[2] * cs[1] - a[3] * sn[1]; v0[3] = a[3] * cs[1] + a[2] * sn[1];
                        v1[0] = b[0] * cs[2] - b[1] * sn[2]; v1[1] = b[1] * cs[2] + b[0] * sn[2];
                        v1[2] = b[2] * cs[3] - b[3] * sn[3]; v1[3] = b[3] * cs[3] + b[2] * sn[3];
                    }
                    u32x4 w; w.x = cvt_pk_bf16(v0[0], v0[1]); w.y = cvt_pk_bf16(v0[2], v0[3]); w.z = cvt_pk_bf16(v1[0], v1[1]); w.w = cvt_pk_bf16(v1[2], v1[3]);
                    *(u32x4*)(rowp + bj * HALF) = w;
                }
            }
    }
};
struct EpiSwiGLU {
    static constexpr bool PERM = true, AFTER_DRAIN = false;
    bf16_t* O; int ldc; const float* part;
    __device__ __forceinline__ void operator()(const f32x4 (&acc)[2][2][4][2], const Unit& u, int wr, int wc, int fr, int fq) const {
        const int row0 = u.pm * BM + wr * 64 + fr;
        float rs[2][4]; row_rstd(part, row0, fq, rs);
        const int col0 = u.pn * HALF + wc * 32 + 8 * fq;
#pragma unroll
        for (int ai = 0; ai < 2; ++ai)
#pragma unroll
            for (int m = 0; m < 4; ++m) {
                const int row = row0 + ai * HALF + m * 16;
                const float r = rs[ai][m];
                float h[8];
#pragma unroll
                for (int n = 0; n < 2; ++n)
#pragma unroll
                    for (int c = 0; c < 4; ++c) {
                        const float g = acc[ai][0][m][n][c] * r, uu = acc[ai][1][m][n][c] * r;
                        h[n * 4 + c] = g * __builtin_amdgcn_rcpf(1.0f + __builtin_amdgcn_exp2f(-1.4426950408889634f * g)) * uu;
                    }
                u32x4 w; w.x = cvt_pk_bf16(h[0], h[1]); w.y = cvt_pk_bf16(h[2], h[3]); w.z = cvt_pk_bf16(h[4], h[5]); w.w = cvt_pk_bf16(h[6], h[7]);
                *(u32x4*)((char*)O + ((unsigned)row * (unsigned)ldc + (unsigned)col0) * 2u) = w;
            }
    }
};
struct EpiResid {
    static constexpr bool PERM = true, AFTER_DRAIN = false;
    bf16_t* XB; float* part;
    __device__ __forceinline__ void operator()(const f32x4 (&acc)[2][2][4][2], const Unit& u, int wr, int wc, int fr, int fq) const {
        const int row0 = u.pm * BM + wr * 64 + fr, col0 = u.pn * BM + wc * 32 + 8 * fq;
#pragma unroll
        for (int ai = 0; ai < 2; ++ai)
#pragma unroll
            for (int m = 0; m < 4; ++m) {
                const int row = row0 + ai * HALF + m * 16;
                float ss = 0.f;
#pragma unroll
                for (int bj = 0; bj < 2; ++bj) {
                    u32x4* xp = (u32x4*)((char*)XB + ((unsigned)row * 1024u + (unsigned)(col0 + bj * HALF)) * 2u);
                    const u32x4 xo = *xp;
                    const f32x4 a0 = acc[ai][bj][m][0], a1 = acc[ai][bj][m][1];
                    float o[8];
                    o[0] = __uint_as_float(xo.x << 16) + a0[0]; o[1] = __uint_as_float(xo.x & 0xffff0000u) + a0[1]; o[2] = __uint_as_float(xo.y << 16) + a0[2]; o[3] = __uint_as_float(xo.y & 0xffff0000u) + a0[3];
                    o[4] = __uint_as_float(xo.z << 16) + a1[0]; o[5] = __uint_as_float(xo.z & 0xffff0000u) + a1[1]; o[6] = __uint_as_float(xo.w << 16) + a1[2]; o[7] = __uint_as_float(xo.w & 0xffff0000u) + a1[3];
                    u32x4 w; w.x = cvt_pk_bf16(o[0], o[1]); w.y = cvt_pk_bf16(o[2], o[3]); w.z = cvt_pk_bf16(o[4], o[5]); w.w = cvt_pk_bf16(o[6], o[7]);
                    *xp = w;
                    ss += ((o[0] * o[0] + o[1] * o[1]) + (o[2] * o[2] + o[3] * o[3])) + ((o[4] * o[4] + o[5] * o[5]) + (o[6] * o[6] + o[7] * o[7]));
                }
                ss += shx<16>(ss); ss = xhalf_sum(ss);
                if (fq == 0) *(float*)((char*)part + ((unsigned)row * 64u + (unsigned)(4 * u.pn + wc) * 4u)) = ss;
            }
    }
};
struct EpiNull {
    static constexpr bool PERM = false, AFTER_DRAIN = false;
    __device__ __forceinline__ void operator()(const f32x4 (&acc)[2][2][4][2], const Unit&, int, int, int, int) const {
#pragma unroll
        for (int ai = 0; ai < 2; ++ai)
#pragma unroll
            for (int bj = 0; bj < 2; ++bj)
#pragma unroll
                for (int m = 0; m < 4; ++m)
#pragma unroll
                    for (int n = 0; n < 2; ++n) asm volatile("" :: "v"(acc[ai][bj][m][n]));
    }
};
template <class Epi, class Sched, bool ALIGN_EPI = false, bool SP2 = false>
__device__ __forceinline__ void gemm_phase(PG8_LAS unsigned char* lds, const Gemm g, const Sched& S, const Epi& E, const int wave_in) {
    int tid_; asm volatile("v_mbcnt_lo_u32_b32 %0, -1, 0\n\tv_mbcnt_hi_u32_b32 %0, -1, %0" : "=v"(tid_)); tid_ += wave_in * 64; asm volatile("" : "+v"(tid_));
    const int tid = tid_, wid = __builtin_amdgcn_readfirstlane(tid >> 6), lane = tid & 63, wr = wid >> 2, wc = wid & 3, fr = lane & 15, fq = lane >> 4;
    const int K = g.K, nt = K / BK;
    unsigned voffA[2], voffB[2];
#pragma unroll
    for (int i = 0; i < 2; ++i) { int R, C; stage_rc(tid * 16 + i * 8192, R, C); const int Rb = Epi::PERM ? ((R & ~31) + perm32(R & 31)) : R;
        voffA[i] = (unsigned)(R * K + C) * 2u; voffB[i] = (unsigned)(Rb * K + C) * 2u; }
    const size_t kstep = (size_t)(BK * 2);
    const size_t hstep = (size_t)HALF * K * 2;
    const size_t tstep = 2 * hstep;
    const unsigned ldsw = (unsigned)wid * 1024u;
    const int aoff = lds_byte(wr * 64 + fr, fq * 8), boff = lds_byte(wc * 32 + fr, fq * 8);
#define PG8_SA(b, h) (((b) * 2 + (h)) * HTB)
#define PG8_SB(b, h) ((4 + (b) * 2 + (h)) * HTB)
#define PG8_STAGE(bufoff, gbase, voff) do { _Pragma("unroll") for (int _i = 0; _i < 2; ++_i) \
        __builtin_amdgcn_global_load_lds((const unsigned*)((const char*)(gbase) + (voff)[_i]), (PG8_LAS unsigned*)(lds + (bufoff) + ldsw + _i * 8192), 16, 0, 0); } while (0)
#define PG8_LDA(dst, b, h) do { _Pragma("unroll") for (int m = 0; m < 4; ++m) _Pragma("unroll") for (int k = 0; k < 2; ++k) dst[m][k] = *(const PG8_LAS bf16x8*)(lds + PG8_SA(b, h) + aoff + m * 2048 + k * 1024); } while (0)
#define PG8_LDB(dst, b, h) do { _Pragma("unroll") for (int n = 0; n < 2; ++n) _Pragma("unroll") for (int k = 0; k < 2; ++k) dst[n][k] = *(const PG8_LAS bf16x8*)(lds + PG8_SB(b, h) + boff + n * 2048 + k * 1024); } while (0)
#define PG8_MMA(ai, bj, At, Bt) do { __builtin_amdgcn_s_setprio(1); _Pragma("unroll") for (int m = 0; m < 4; ++m) _Pragma("unroll") for (int n = 0; n < 2; ++n) _Pragma("unroll") for (int k = 0; k < 2; ++k) \
        acc[ai][bj][m][n] = __builtin_amdgcn_mfma_f32_16x16x32_bf16(Bt[n][k], At[m][k], acc[ai][bj][m][n], 0, 0, 0); __builtin_amdgcn_s_setprio(0); } while (0)
#define PG8_WAIT_V(n) asm volatile("s_waitcnt vmcnt(" #n ")" ::: "memory")
#define PG8_WAIT_L(n) asm volatile("s_waitcnt lgkmcnt(" #n ")" ::: "memory")
#define PG8_BAR __builtin_amdgcn_s_barrier()
#define PG8_SCHED __builtin_amdgcn_sched_barrier(0)
    Unit cur, nxt; int ui = 0;
    if (!S.next(0, cur)) return;
    f32x4 acc[2][2][4][2];
#pragma unroll
    for (int a = 0; a < 2; ++a)
#pragma unroll
        for (int b = 0; b < 2; ++b)
#pragma unroll
            for (int m = 0; m < 4; ++m)
#pragma unroll
                for (int n = 0; n < 2; ++n) acc[a][b][m][n] = (f32x4){0.f, 0.f, 0.f, 0.f};
    bf16x8 At[4][2], B0[2][2], B1[2][2];
    const char* cA = (const char*)g.A + (size_t)cur.pm * tstep; const char* cB = (const char*)g.Bt + (size_t)cur.pn * tstep;
    S.a_ready(cur);
    if constexpr (SP2) {
        PG8_STAGE(PG8_SB(0, 0), cB, voffB); PG8_STAGE(PG8_SB(0, 1), cB + hstep, voffB); PG8_STAGE(PG8_SA(0, 0), cA, voffA); PG8_STAGE(PG8_SA(0, 1), cA + hstep, voffA);
        if (wr == 1) PG8_BAR;
        PG8_WAIT_V(2); PG8_BAR;
        PG8_STAGE(PG8_SB(1, 0), cB + kstep, voffB); PG8_STAGE(PG8_SA(1, 0), cA + kstep, voffA); PG8_STAGE(PG8_SB(1, 1), cB + hstep + kstep, voffB);
        PG8_WAIT_V(6); PG8_BAR;
    } else {
        PG8_STAGE(PG8_SB(0, 0), cB, voffB); PG8_STAGE(PG8_SA(0, 0), cA, voffA); PG8_STAGE(PG8_SB(0, 1), cB + hstep, voffB); PG8_STAGE(PG8_SA(0, 1), cA + hstep, voffA);
        if (wr == 1) PG8_BAR;
        PG8_WAIT_V(4); PG8_BAR;
        PG8_STAGE(PG8_SB(1, 0), cB + kstep, voffB); PG8_STAGE(PG8_SA(1, 0), cA + kstep, voffA); PG8_STAGE(PG8_SB(1, 1), cB + hstep + kstep, voffB);
        PG8_WAIT_V(6); PG8_BAR;
    }
    for (;;) {
        const bool has_next = S.next(ui + 1, nxt);
        const char* nA = has_next ? (const char*)g.A + (size_t)nxt.pm * tstep : cA; const char* nB = has_next ? (const char*)g.Bt + (size_t)nxt.pn * tstep : cB;
        for (int t = 0; t < nt; t += 2) {
            const bool last = (t == nt - 2);
            const char* a1 = cA + (size_t)(t + 1) * kstep;
            const char* a2 = last ? nA : cA + (size_t)(t + 2) * kstep; const char* b2 = last ? nB : cB + (size_t)(t + 2) * kstep;
            const char* a3 = a2 + kstep; const char* b3 = b2 + kstep;
            if (last && has_next) S.a_ready(nxt);
            if constexpr (SP2) {
            PG8_LDB(B0, 0, 0); PG8_LDB(B1, 0, 1); PG8_SCHED; PG8_LDA(At, 0, 0); PG8_STAGE(PG8_SA(1, 1), a1 + hstep, voffA);
            PG8_WAIT_V(8); PG8_WAIT_L(0); PG8_BAR; PG8_MMA(0, 0, At, B0); PG8_MMA(0, 1, At, B1); PG8_BAR; PG8_SCHED;
            PG8_LDA(At, 0, 1); PG8_STAGE(PG8_SB(0, 0), b2, voffB); PG8_STAGE(PG8_SB(0, 1), b2 + hstep, voffB); PG8_STAGE(PG8_SA(0, 0), a2, voffA);
            PG8_WAIT_V(8); PG8_WAIT_L(0); PG8_BAR; PG8_MMA(1, 0, At, B0); PG8_MMA(1, 1, At, B1); PG8_BAR; PG8_SCHED;
            PG8_LDB(B0, 1, 0); PG8_LDB(B1, 1, 1); PG8_SCHED; PG8_LDA(At, 1, 0); PG8_STAGE(PG8_SA(0, 1), a2 + hstep, voffA);
            PG8_WAIT_V(8); PG8_WAIT_L(0); PG8_BAR; PG8_MMA(0, 0, At, B0); PG8_MMA(0, 1, At, B1); PG8_BAR; PG8_SCHED;
            PG8_LDA(At, 1, 1); PG8_STAGE(PG8_SB(1, 0), b3, voffB); PG8_STAGE(PG8_SB(1, 1), b3 + hstep, voffB); PG8_STAGE(PG8_SA(1, 0), a3, voffA);
            PG8_WAIT_V(8); PG8_WAIT_L(0); PG8_BAR; PG8_MMA(1, 0, At, B0); PG8_MMA(1, 1, At, B1); PG8_BAR; PG8_SCHED;
            } else {
            PG8_LDB(B0, 0, 0); PG8_SCHED; PG8_LDA(At, 0, 0); PG8_STAGE(PG8_SA(1, 1), a1 + hstep, voffA);
            PG8_WAIT_L(8); PG8_BAR; PG8_WAIT_L(0); PG8_MMA(0, 0, At, B0); PG8_BAR; PG8_SCHED;
            PG8_LDB(B1, 0, 1); PG8_STAGE(PG8_SB(0, 0), b2, voffB);
            PG8_BAR; PG8_WAIT_L(0); PG8_MMA(0, 1, At, B1); PG8_BAR;
            PG8_LDA(At, 0, 1); PG8_STAGE(PG8_SA(0, 0), a2, voffA);
            PG8_BAR; PG8_WAIT_L(0); PG8_MMA(1, 0, At, B0); PG8_BAR; PG8_SCHED;
            PG8_STAGE(PG8_SB(0, 1), b2 + hstep, voffB);
            PG8_WAIT_V(6); PG8_BAR; PG8_MMA(1, 1, At, B1); PG8_BAR;
            PG8_LDB(B0, 1, 0); PG8_SCHED; PG8_LDA(At, 1, 0); PG8_STAGE(PG8_SA(0, 1), a2 + hstep, voffA);
            PG8_WAIT_L(8); PG8_BAR; PG8_WAIT_L(0); PG8_MMA(0, 0, At, B0); PG8_BAR; PG8_SCHED;
            PG8_LDB(B1, 1, 1); PG8_STAGE(PG8_SB(1, 0), b3, voffB);
            PG8_BAR; PG8_WAIT_L(0); PG8_MMA(0, 1, At, B1); PG8_BAR;
            PG8_LDA(At, 1, 1); PG8_STAGE(PG8_SA(1, 0), a3, voffA);
            PG8_BAR; PG8_WAIT_L(0); PG8_MMA(1, 0, At, B0); PG8_BAR; PG8_SCHED;
            PG8_STAGE(PG8_SB(1, 1), b3 + hstep, voffB);
            PG8_WAIT_V(6); PG8_BAR; PG8_MMA(1, 1, At, B1); PG8_BAR;
            }
        }
        if constexpr (ALIGN_EPI) { if (wr == 0) PG8_BAR; }
        if constexpr (!Epi::AFTER_DRAIN) { E(acc, cur, wr, wc, fr, fq); S.done(cur); }
        if (!has_next) break;
#pragma unroll
        for (int a = 0; a < 2; ++a)
#pragma unroll
            for (int b = 0; b < 2; ++b)
#pragma unroll
                for (int m = 0; m < 4; ++m)
#pragma unroll
                    for (int n = 0; n < 2; ++n) acc[a][b][m][n] = (f32x4){0.f, 0.f, 0.f, 0.f};
        cur = nxt; cA = nA; cB = nB; ++ui;
        if constexpr (ALIGN_EPI) { if (wr == 1) PG8_BAR; }
    }
    PG8_WAIT_V(0);
    if constexpr (!ALIGN_EPI) { if (wr == 0) PG8_BAR; }
    PG8_BAR;
    if constexpr (Epi::AFTER_DRAIN) { E.fused(acc, cur, wr, wc, fr, fq, lds, wid, lane); S.done(cur); }
#undef PG8_SA
#undef PG8_SB
#undef PG8_STAGE
#undef PG8_LDA
#undef PG8_LDB
#undef PG8_MMA
#undef PG8_WAIT_V
#undef PG8_WAIT_L
#undef PG8_BAR
#undef PG8_SCHED
}
}
#define GAS __attribute__((address_space(1)))
#define LAS __attribute__((address_space(3)))
typedef unsigned short bf16;
typedef unsigned v4u __attribute__((ext_vector_type(4)));
typedef float f32x4 __attribute__((ext_vector_type(4)));
typedef short bf16x8 __attribute__((ext_vector_type(8)));
typedef GAS unsigned gu32;
typedef GAS unsigned long long gu64;
#define RLX_AGENT __ATOMIC_RELAXED, __HIP_MEMORY_SCOPE_AGENT
#define LDS_WAIT() asm volatile("s_waitcnt lgkmcnt(0)" ::: "memory")
#define VM_WAIT() asm volatile("s_waitcnt vmcnt(0)" ::: "memory")
__device__ __forceinline__ unsigned long long rt() { return __builtin_amdgcn_s_memrealtime(); }
__device__ __forceinline__ unsigned f2bf(float f) { unsigned u = __builtin_bit_cast(unsigned, f); return (u + 0x7fffu + ((u >> 16) & 1u)) >> 16; }
__device__ __forceinline__ unsigned pk2(float lo, float hi) { return f2bf(lo) | (f2bf(hi) << 16); }

#define XB_TMO      128
#define XB_XCNT(j)  (256  + 64 * (j))
#define XB_XSUB(j)  (1280 + 64 * (j))
#define XB_XGEN(j)  (2304 + 64 * (j))
#define XB_TOP      3328
#define XB_TOPGEN   3392
#define XCD_BAR_WORDS 3456
#define XB_SPIN_CAP (1u << 18)

__device__ __forceinline__ unsigned xb_ld(unsigned* p)              { return __hip_atomic_load(p, __ATOMIC_RELAXED, __HIP_MEMORY_SCOPE_AGENT); }
__device__ __forceinline__ unsigned xb_add(unsigned* p, unsigned v) { return __hip_atomic_fetch_add(p, v, __ATOMIC_RELAXED, __HIP_MEMORY_SCOPE_AGENT); }
__device__ __forceinline__ unsigned xb_xcc_id() { return (unsigned)__builtin_amdgcn_s_getreg((3 << 11) | 20) & 0xFu; }
#define XB_SPIN(cond, bar) do { unsigned _sp = 0; while (cond) { __builtin_amdgcn_s_sleep(1); \
    if ((++_sp & 255u) == 0u) { if (xb_ld(&(bar)[XB_TMO])) break; if (_sp > XB_SPIN_CAP) { atomicAdd(&(bar)[XB_TMO], 1u); break; } } } } while (0)

struct XcdBarrier {
    unsigned* bar; unsigned x;
    volatile LAS unsigned* st;
};

__device__ __forceinline__ XcdBarrier xcd_barrier_post(unsigned* bar, volatile LAS unsigned* st) {
    XcdBarrier b; b.bar = bar; b.x = xb_xcc_id(); b.st = st;
    if (threadIdx.x == 0) (void)xb_add(&bar[XB_XCNT(b.x)], 1u);
    return b;
}
__device__ __forceinline__ void xcd_barrier_complete(unsigned* bar, unsigned x, unsigned& nloc, unsigned& nx) {
    const unsigned G = gridDim.x * gridDim.y * gridDim.z;
    unsigned sum, cnt, mine, sp = 0u;
    for (;;) {
        sum = 0u; cnt = 0u; mine = 0u;
#pragma unroll
        for (unsigned j = 0; j < 16; ++j) { const unsigned c = xb_ld(&bar[XB_XCNT(j)]); sum += c; cnt += (c > 0u) ? 1u : 0u; mine = (j == x) ? c : mine; }
        if (sum == G) break;
        __builtin_amdgcn_s_sleep(1);
        if ((++sp & 255u) == 0u) { if (xb_ld(&bar[XB_TMO])) break; if (sp > XB_SPIN_CAP) { atomicAdd(&bar[XB_TMO], 1u); break; } }
    }
    nloc = mine > 0u ? mine : 1u; nx = cnt > 0u ? cnt : 1u;
}

__device__ __forceinline__ void xcd_barrier(const XcdBarrier& b) {
    asm volatile("s_waitcnt vmcnt(0)" ::: "memory");
    __syncthreads();
    if (threadIdx.x == 0) {
        unsigned* bar = b.bar;
        __builtin_amdgcn_s_waitcnt(0);
        unsigned nloc = b.st[0], nx = b.st[1];
        if (nloc == 0u) { xcd_barrier_complete(bar, b.x, nloc, nx); b.st[0] = nloc; b.st[1] = nx; }
        const unsigned old = xb_add(&bar[XB_XSUB(b.x)], 1u);
        const unsigned gen = old / nloc;
        if (old + 1u == (gen + 1u) * nloc) {
            __builtin_amdgcn_fence(__ATOMIC_RELEASE, "agent");
            asm volatile("s_waitcnt vmcnt(0)" ::: "memory");
            const unsigned og = xb_add(&bar[XB_TOP], 1u);
            const unsigned tg = og / nx;
            if (og + 1u == (tg + 1u) * nx) xb_add(&bar[XB_TOPGEN], 1u);
            else XB_SPIN(xb_ld(&bar[XB_TOPGEN]) == tg, bar);
            __builtin_amdgcn_fence(__ATOMIC_ACQUIRE, "agent");
            xb_add(&bar[XB_XGEN(b.x)], 1u);
            asm volatile("s_waitcnt vmcnt(0)" ::: "memory");
        } else {
            XB_SPIN(xb_ld(&bar[XB_XGEN(b.x)]) == gen, bar);
            __builtin_amdgcn_fence(__ATOMIC_ACQUIRE, "agent");
            asm volatile("s_waitcnt vmcnt(0)" ::: "memory");
        }
    }
    __syncthreads();
}


constexpr int NWAVES = 8;
constexpr int M = 16384, SEQ = 8192, D = 1024, DFF = 2816, MW = 3088, MP = 3072, AW = 1536;
constexpr float EPS = 1e-6f;
constexpr size_t MiB = 1u << 20;
constexpr size_t WS_CTL = 0, CTL_ZERO_BYTES = 1 * MiB;
constexpr size_t WS_PART = 1 * MiB;
constexpr size_t WS_GATES = 2 * MiB;
constexpr size_t WS_SMALL = 3 * MiB;
constexpr size_t WS_ROPE = 4 * MiB;
constexpr size_t WS_NBUF = 8 * MiB;
constexpr size_t WS_WG = 9 * MiB;
constexpr size_t WS_W = 10 * MiB;
constexpr size_t W_MIN = WS_W, W_MOUT = W_MIN + 12 * MiB, W_AIN = W_MOUT + 4 * MiB, W_AOUT = W_AIN + 6 * MiB, W_FIN = W_AOUT + 4 * MiB, W_FOUT = W_FIN + 44 * MiB;
constexpr size_t WS_XB = 102 * MiB;
constexpr size_t WS_HS = 134 * MiB;
constexpr size_t WS_PROJ = 166 * MiB;
constexpr size_t WS_KV = 262 * MiB;
constexpr size_t WS_END = 326 * MiB;
static_assert(W_FOUT + 22 * MiB == WS_XB, "weight map");
constexpr int CW_BAR = 4096;

constexpr int RING_OFF = 0, RING_BYTES = 131072;
constexpr int LDSCTL_OFF = RING_BYTES, MISC_OFF = LDSCTL_OFF + 320;
constexpr int LDS_BYTES = 147456;

using pg8::shx; using pg8::xhalf_sum; using pg8::xhalf_max;
__device__ __forceinline__ float wave_sum(float v) { v += shx<1>(v); v += shx<2>(v); v += shx<4>(v); v += shx<8>(v); v += shx<16>(v); return xhalf_sum(v); }
__device__ __forceinline__ float wave_max(float v) { v = fmaxf(v, shx<1>(v)); v = fmaxf(v, shx<2>(v)); v = fmaxf(v, shx<4>(v)); v = fmaxf(v, shx<8>(v)); v = fmaxf(v, shx<16>(v)); return xhalf_max(v); }
#define DPPF(old, src, ctrl, rm) __int_as_float(__builtin_amdgcn_update_dpp(__float_as_int(old), __float_as_int(src), ctrl, rm, 0xf, false))
__device__ __forceinline__ float wscan_add(float v) {
    v += DPPF(0.f, v, 0x111, 0xf); v += DPPF(0.f, v, 0x112, 0xf); v += DPPF(0.f, v, 0x114, 0xf); v += DPPF(0.f, v, 0x118, 0xf); v += DPPF(0.f, v, 0x142, 0xa); v += DPPF(0.f, v, 0x143, 0xc); return v; }
__device__ __forceinline__ float wscan_max(float v) {
    const float ni = -INFINITY;
    v = fmaxf(v, DPPF(ni, v, 0x111, 0xf)); v = fmaxf(v, DPPF(ni, v, 0x112, 0xf)); v = fmaxf(v, DPPF(ni, v, 0x114, 0xf)); v = fmaxf(v, DPPF(ni, v, 0x118, 0xf)); v = fmaxf(v, DPPF(ni, v, 0x142, 0xa)); v = fmaxf(v, DPPF(ni, v, 0x143, 0xc)); return v; }
__device__ __forceinline__ float wave_shr1(float v, float fill) { return DPPF(fill, v, 0x138, 0xf); }
__device__ __forceinline__ float lane63(float v) { return __int_as_float(__builtin_amdgcn_readlane(__float_as_int(v), 63)); }
__device__ __forceinline__ float bf2f(unsigned short b) { return __uint_as_float((unsigned)b << 16); }
__device__ __forceinline__ float log_sigmoidf(float x) { return fminf(x, 0.f) - __logf(1.0f + __expf(-fabsf(x))); }

struct Args { const float* in[14]; float* out; unsigned char* ws; int ph_lo, ph_hi, dup, pad; };

struct ColMap {
    int type;
    __device__ __forceinline__ int dst(int s) const {
        if (type == 2) { if (s >= 1280) return s; const int p = s & 63; return (s & ~63) + (p < 32 ? 2 * p : 2 * (p - 32) + 1); }
        if (type == 3) { return s < DFF ? 256 * (s >> 7) + (s & 127) : 256 * ((s - DFF) >> 7) + 128 + ((s - DFF) & 127); }
        return s;
    }
    __device__ __forceinline__ float scale(int s) const {
        if (type == 1) return s < 512 ? 0.08838834764831845f : 1.0f;
        if (type == 2) return s < 1024 ? 0.125f : 1.0f;
        return 1.0f;
    }
};
__device__ __forceinline__ void wt_item(const float* W, int ldn, int K, const float* nw, bf16* WT, ColMap mp, LAS float* scr, int item, int nblk, int lane) {
    const int kb = item / nblk, nb = item % nblk, k0 = 64 * kb, s0 = 32 * nb;
    const int ks = lane >> 3, c4 = lane & 7;
    f32x4 v[8];
#pragma unroll
    for (int i = 0; i < 8; ++i) v[i] = *(const GAS f32x4*)(W + (size_t)(k0 + 8 * i + ks) * ldn + s0 + 4 * c4);
    const float sc = mp.scale(s0 + 4 * c4);
#pragma unroll
    for (int i = 0; i < 8; ++i) { const float w = nw ? nw[k0 + 8 * i + ks] * sc : sc; LAS float* d = scr + (8 * i + ks) * 33 + 4 * c4;
        d[0] = v[i].x * w; d[1] = v[i].y * w; d[2] = v[i].z * w; d[3] = v[i].w * w; }
    LDS_WAIT(); asm volatile("" ::: "memory");
    const int c = lane & 7;
#pragma unroll
    for (int j = 0; j < 4; ++j) { const int n = (lane >> 3) + 8 * j; const LAS float* sp = scr + (8 * c) * 33 + n;
        v4u o; o.x = pk2(sp[0 * 33], sp[1 * 33]); o.y = pk2(sp[2 * 33], sp[3 * 33]); o.z = pk2(sp[4 * 33], sp[5 * 33]); o.w = pk2(sp[6 * 33], sp[7 * 33]);
        *(GAS v4u*)(WT + (size_t)mp.dst(s0 + n) * K + k0 + 8 * c) = o; }
    LDS_WAIT(); asm volatile("" ::: "memory");
}

struct Ptrs {
    const float *x; const int* pos; const float *norm_mix_w, *norm_ffn_w, *norm_final_w, *mlstm_w_in, *mlstm_b_gate, *mlstm_norm_w, *mlstm_w_out, *attn_w_in, *attn_sink, *attn_w_out, *ffn_w_in, *ffn_w_out;
    float* out; unsigned char* ws;
};

__device__ __forceinline__ void p0_prologue(const Ptrs& P, LAS unsigned char* lds, int vcu, int G, int wave, int lane) {
    LAS float* scr = (LAS float*)(lds + RING_OFF + wave * 16384);
    const int gw = vcu * NWAVES + wave, NGW = G * NWAVES;
    constexpr int I_MIN = 16 * 96, I_SQ = 16 * 32, I_AIN = 16 * 48, I_FIN = 16 * 176, I_FOUT = 44 * 32;
    constexpr int NITEMS = 2 * I_MIN + 2 * I_SQ + 2 * I_AIN + 2 * I_SQ + 4 * I_FIN + 4 * I_FOUT;
    unsigned char* ws = P.ws;
    for (int it = gw; it < NITEMS; it += NGW) {
        int r = it;
        if (r < 2 * I_MIN) { const int L = r / I_MIN; r %= I_MIN; wt_item(P.mlstm_w_in + (size_t)L * D * MW, MW, D, P.norm_mix_w + (2 * L) * D, (bf16*)(ws + W_MIN) + (size_t)L * MP * D, ColMap{1}, scr, r, MP / 32, lane); continue; } r -= 2 * I_MIN;
        if (r < 2 * I_SQ) { const int L = r / I_SQ; r %= I_SQ; wt_item(P.mlstm_w_out + (size_t)L * D * D, D, D, nullptr, (bf16*)(ws + W_MOUT) + (size_t)L * D * D, ColMap{0}, scr, r, D / 32, lane); continue; } r -= 2 * I_SQ;
        if (r < 2 * I_AIN) { const int L = r / I_AIN; r %= I_AIN; wt_item(P.attn_w_in + (size_t)L * D * AW, AW, D, P.norm_mix_w + (2 * L + 1) * D, (bf16*)(ws + W_AIN) + (size_t)L * AW * D, ColMap{2}, scr, r, AW / 32, lane); continue; } r -= 2 * I_AIN;
        if (r < 2 * I_SQ) { const int L = r / I_SQ; r %= I_SQ; wt_item(P.attn_w_out + (size_t)L * D * D, D, D, nullptr, (bf16*)(ws + W_AOUT) + (size_t)L * D * D, ColMap{0}, scr, r, D / 32, lane); continue; } r -= 2 * I_SQ;
        if (r < 4 * I_FIN) { const int L = r / I_FIN; r %= I_FIN; wt_item(P.ffn_w_in + (size_t)L * D * 2 * DFF, 2 * DFF, D, P.norm_ffn_w + L * D, (bf16*)(ws + W_FIN) + (size_t)L * 2 * DFF * D, ColMap{3}, scr, r, 2 * DFF / 32, lane); continue; } r -= 4 * I_FIN;
        { const int L = r / I_FOUT; r %= I_FOUT; wt_item(P.ffn_w_out + (size_t)L * DFF * D, D, DFF, nullptr, (bf16*)(ws + W_FOUT) + (size_t)L * D * DFF, ColMap{0}, scr, r, D / 32, lane); }
    }
    float* part = (float*)(ws + WS_PART); bf16* xb = (bf16*)(ws + WS_XB);
    for (int m = gw; m < M; m += NGW) {
        const GAS f32x4* xr = (const GAS f32x4*)(P.x + (size_t)m * D) + lane;
        GAS unsigned long long* o8 = (GAS unsigned long long*)(xb + (size_t)m * D) + lane;
        float s = 0.f;
#pragma unroll
        for (int j = 0; j < 4; ++j) { const f32x4 v = xr[64 * j]; s += (v.x * v.x + v.y * v.y) + (v.z * v.z + v.w * v.w);
            o8[64 * j] = (unsigned long long)pk2(v.x, v.y) | ((unsigned long long)pk2(v.z, v.w) << 32); }
        s = wave_sum(s);
        if (lane < 16) part[(size_t)m * 16 + lane] = lane == 0 ? s : 0.f;
    }
    float* cosT = (float*)(ws + WS_ROPE); float* sinT = cosT + (size_t)M * 32;
    for (int idx = gw * 64 + lane; idx < M * 32; idx += NGW * 64) {
        const int t = idx >> 5, i = idx & 31;
        const float inv = powf(10000.0f, -(float)i / 32.0f);
        const float ang = (float)P.pos[t] * inv;
        cosT[idx] = cosf(ang); sinT[idx] = sinf(ang);
    }
    bf16* wg = (bf16*)(ws + WS_WG);
    for (int idx = gw * 64 + lane; idx < 2 * 16 * 1024; idx += NGW * 64) {
        const int L = idx >> 14, g = (idx >> 10) & 15, k = idx & 1023;
        wg[idx] = (bf16)f2bf(P.mlstm_w_in[(size_t)L * D * MW + (size_t)k * MW + 3072 + g] * P.norm_mix_w[(2 * L) * D + k]);
    }
}

typedef float f32x4v __attribute__((ext_vector_type(4)));
__device__ __forceinline__ void gates_step(const Ptrs& P, int L, LAS unsigned char* lds, int blk, int wave, int lane) {
    unsigned char* ws = P.ws;
    const bf16* xb = (const bf16*)(ws + WS_XB); const bf16* wg = (const bf16*)(ws + WS_WG) + (size_t)L * 16 * 1024;
    const float* part = (const float*)(ws + WS_PART); float* gates = (float*)(ws + WS_GATES);
    const int tg = wave & 3, kh = wave >> 2, fr = lane & 15, fq = lane >> 4;
    const int row0 = blk * 64 + tg * 16;
    f32x4v acc = {0.f, 0.f, 0.f, 0.f};
    const bf16* ap = xb + (size_t)(row0 + fr) * D + kh * 512 + fq * 8;
    const bf16* bp = wg + (size_t)fr * 1024 + kh * 512 + fq * 8;
#pragma unroll 4
    for (int s = 0; s < 16; ++s) {
        const bf16x8 a = *(const bf16x8*)(ap + s * 32), b = *(const bf16x8*)(bp + s * 32);
        acc = __builtin_amdgcn_mfma_f32_16x16x32_bf16(a, b, acc, 0, 0, 0);
    }
    LAS f32x4v* ex = (LAS f32x4v*)(lds + RING_OFF);
    if (kh == 1) ex[tg * 64 + lane] = acc;
    __syncthreads();
    if (kh == 0) {
        const f32x4v o = ex[tg * 64 + lane]; acc = acc + o;
        const int g = fr; const float bias = P.mlstm_b_gate[L * 16 + g];
#pragma unroll
        for (int r = 0; r < 4; ++r) {
            const int row = row0 + 4 * fq + r;
            float s = 0.f;
#pragma unroll
            for (int p = 0; p < 4; ++p) { const f32x4 pv = *(const f32x4*)(part + (size_t)row * 16 + 4 * p); s += (pv.x + pv.y) + (pv.z + pv.w); }
            const float rstd = rsqrtf(s * (1.0f / 1024.0f) + EPS);
            float v = acc[r] * rstd + bias;
            if (g & 4) v = log_sigmoidf(v);
            gates[(size_t)row * 16 + g] = v;
        }
    }
    __syncthreads();
}

typedef float f32x16 __attribute__((ext_vector_type(16)));
typedef short s16x4 __attribute__((ext_vector_type(4)));
typedef unsigned v2u __attribute__((ext_vector_type(2)));
constexpr int XTRA_OFF = LDSCTL_OFF + 1024;
static_assert(XTRA_OFF + 15 * 1024 <= LDS_BYTES, "LDS map");

__device__ __forceinline__ int crow(int r, int hh) { return (r & 3) + 8 * (r >> 2) + 4 * hh; }
__device__ __forceinline__ s16x4 tr_read(LAS const unsigned char* p) { return __builtin_bit_cast(s16x4, __builtin_amdgcn_ds_read_tr16_b64_v4i16((LAS s16x4*)p)); }
__device__ __forceinline__ bf16x8 cat8(s16x4 lo, s16x4 hi) { return (bf16x8){lo[0], lo[1], lo[2], lo[3], hi[0], hi[1], hi[2], hi[3]}; }
__device__ __forceinline__ unsigned cvtpk(float lo, float hi) { unsigned r; asm volatile("v_cvt_pk_bf16_f32 %0, %1, %2" : "=v"(r) : "v"(lo), "v"(hi)); return r; }

constexpr int AT_ROWS = 320, AT_K = 0, AT_V = AT_ROWS * 128, AT_WS = 2 * AT_ROWS * 128, AT_OST = AT_WS + 2048;
static_assert(AT_OST + 8 * 4096 <= RING_BYTES, "attention LDS map");
__device__ __forceinline__ void attn_phase(const bf16* proj, const float* sink, bf16* hs, LAS unsigned char* lds, int vcu, int G, int tid) {
    const int wave = __builtin_amdgcn_readfirstlane(tid >> 6), g = wave & 3, rb = wave >> 2;
    LAS float* wsf = (LAS float*)(lds + AT_WS) + wave * 64;
    LAS unsigned char* ost = lds + AT_OST + wave * 4096;
    v4u kreg[5], vreg[5]; bf16x8 qreg[4];
#define AT_LOAD(item_) do { const int b_ = (item_) >> 9, hkv_ = ((item_) >> 7) & 3, q0_ = ((item_) & 127) * 64; \
        _Pragma("unroll") for (int i = 0; i < 5; ++i) { const int idx = tid_i + 512 * i, row = idx >> 3, c = idx & 7, kp = q0_ - 128 + row; \
            kreg[i] = (v4u){0u, 0u, 0u, 0u}; vreg[i] = (v4u){0u, 0u, 0u, 0u}; \
            if (kp >= 0 && kp < SEQ) { const bf16* src = proj + (size_t)(b_ * SEQ + kp) * AW + 1024 + hkv_ * 64 + c * 8; kreg[i] = *(const v4u*)src; vreg[i] = *(const v4u*)(src + 256); } } \
        { const bf16* qp = proj + (size_t)(b_ * SEQ + q0_ + 32 * rb + (tid_i & 31)) * AW + (hkv_ * 4 + g) * 64 + 8 * ((tid_i >> 5) & 1); \
          _Pragma("unroll") for (int s = 0; s < 4; ++s) qreg[s] = *(const bf16x8*)(qp + 16 * s); } } while (0)
    { int tid_i = tid; if (vcu < 1024) AT_LOAD(vcu); }
    for (int item = vcu; item < 1024; item += G) {
        int tid_i = tid; asm volatile("" : "+v"(tid_i));
        const int lane = tid_i & 63, r32 = lane & 31, hh = lane >> 5;
        const int b = item >> 9, hkv = (item >> 7) & 3, qb = item & 127, q0 = qb * 64, hq = hkv * 4 + g;
#pragma unroll
        for (int i = 0; i < 5; ++i) {
            const int idx = tid_i + 512 * i, row = idx >> 3, c = idx & 7;
            *(LAS v4u*)(lds + AT_K + row * 128 + ((c ^ ((row >> 1) & 7)) << 4)) = kreg[i];
            *(LAS v4u*)(lds + AT_V + row * 128 + ((c ^ (((row >> 1) & 1) << 2)) << 4)) = vreg[i];
        }
        bf16x8 qf[4];
#pragma unroll
        for (int s = 0; s < 4; ++s) qf[s] = qreg[s];
        __syncthreads();
        if (item + G < 1024) AT_LOAD(item + G);
        float m = sink[hq], l = hh == 0 ? 1.0f : 0.0f;
        f32x16 o[2]; o[0] = (f32x16){}; o[1] = (f32x16){};
        const int qpos = q0 + 32 * rb + r32;
        for (int kb = 0; kb < 9; ++kb) {
            const int krow0 = 32 * rb + 32 * kb;
            f32x16 x = (f32x16){};
            { const int kr = krow0 + r32; LAS const unsigned char* kbp = lds + AT_K + kr * 128; const int sw = (kr >> 1) & 7;
#pragma unroll
              for (int s = 0; s < 4; ++s) { const bf16x8 kf = *(LAS const bf16x8*)(kbp + (((2 * s + hh) ^ sw) << 4)); x = __builtin_amdgcn_mfma_f32_32x32x16_bf16(kf, qf[s], x, 0, 0, 0); } }
            float bmax = -INFINITY;
#pragma unroll
            for (int r = 0; r < 16; ++r) { const int kp = q0 - 128 + krow0 + crow(r, hh); const int dd = qpos - kp;
                const bool ok = (kp >= 0) && (kp < SEQ) && (dd <= 128) && (dd >= -128);
                x[r] = ok ? x[r] : -INFINITY; bmax = fmaxf(bmax, x[r]); }
            bmax = xhalf_max(bmax);
            const float mn = fmaxf(m, bmax), f = __expf(m - mn);
            m = mn;
            float ps = 0.f;
#pragma unroll
            for (int r = 0; r < 16; ++r) { x[r] = __expf(x[r] - mn); ps += x[r]; }
            l = l * f + ps;
            if (hh == 0) wsf[r32] = f;
            bf16x8 pa[2];
#pragma unroll
            for (int s = 0; s < 2; ++s) { v4u w; w.x = cvtpk(x[8 * s + 0], x[8 * s + 1]); w.y = cvtpk(x[8 * s + 2], x[8 * s + 3]); w.z = cvtpk(x[8 * s + 4], x[8 * s + 5]); w.w = cvtpk(x[8 * s + 6], x[8 * s + 7]); pa[s] = __builtin_bit_cast(bf16x8, w); }
            LDS_WAIT();
#pragma unroll
            for (int r = 0; r < 16; ++r) { const float fr_ = wsf[crow(r, hh)]; o[0][r] *= fr_; o[1][r] *= fr_; }
#pragma unroll
            for (int s = 0; s < 2; ++s)
#pragma unroll
                for (int eb = 0; eb < 2; ++eb) {
                    const int R0 = krow0 + 16 * s + 4 * hh + ((lane & 15) >> 2);
                    const int ch = 4 * eb + 2 * ((lane >> 4) & 1) + ((lane & 3) >> 1);
                    const s16x4 lo = tr_read(lds + AT_V + R0 * 128 + ((ch ^ (((R0 >> 1) & 1) << 2)) << 4) + 8 * (lane & 1));
                    const int R1 = R0 + 8;
                    const s16x4 hi = tr_read(lds + AT_V + R1 * 128 + ((ch ^ (((R1 >> 1) & 1) << 2)) << 4) + 8 * (lane & 1));
                    o[eb] = __builtin_amdgcn_mfma_f32_32x32x16_bf16(pa[s], cat8(lo, hi), o[eb], 0, 0, 0);
                }
        }
        l = xhalf_sum(l);
        if (hh == 0) wsf[32 + r32] = l;
        LDS_WAIT();
#pragma unroll
        for (int r = 0; r < 16; ++r) { const int t = crow(r, hh); const float rl = 1.0f / wsf[32 + t];
            *(LAS unsigned short*)(ost + t * 128 + r32 * 2) = (unsigned short)f2bf(o[0][r] * rl); *(LAS unsigned short*)(ost + t * 128 + 64 + r32 * 2) = (unsigned short)f2bf(o[1][r] * rl); }
        LDS_WAIT();
        { bf16* op = hs + (size_t)(b * SEQ + q0 + 32 * rb) * D + hq * 64;
#pragma unroll
          for (int i = 0; i < 4; ++i) { const int row = i * 8 + (lane >> 3), chn = lane & 7; const v4u v = *(LAS const v4u*)(ost + row * 128 + chn * 16); *(v4u*)(op + (size_t)row * D + chn * 8) = v; } }
        __syncthreads();
    }
#undef AT_LOAD
}

__device__ __forceinline__ int qk8(int row, int g8) { return row * 256 + ((g8 ^ (row & 31)) << 3); }
__device__ __forceinline__ int vt16(int row, int c16, int rowbytes) { return row * rowbytes + ((c16 ^ ((row & 3) << 2)) << 4); }
__device__ __forceinline__ void unpack8(v4u w, float (&f)[8]) {
    f[0] = __uint_as_float(w.x << 16); f[1] = __uint_as_float(w.x & 0xffff0000u); f[2] = __uint_as_float(w.y << 16); f[3] = __uint_as_float(w.y & 0xffff0000u);
    f[4] = __uint_as_float(w.z << 16); f[5] = __uint_as_float(w.z & 0xffff0000u); f[6] = __uint_as_float(w.w << 16); f[7] = __uint_as_float(w.w & 0xffff0000u);
}
constexpr int ML_A = 0, ML_B = 32768, ML_V = 65536;

__device__ __forceinline__ void mlstm_chunk_phase(const bf16* proj, const float* gates, bf16* kvb, float* nbuf, float* blam, LAS unsigned char* lds, int vcu, int G, int tid) {
    const int wave = __builtin_amdgcn_readfirstlane(tid >> 6), db = wave & 3, eh = wave >> 2;
    LAS float* gs = (LAS float*)(lds + XTRA_OFF);
    LAS float* wv = gs + 512;
    for (int item = vcu; item < 512; item += G) {
        int tid_i = tid; asm volatile("" : "+v"(tid_i));
        const int tid = tid_i, lane = tid & 63, hh = lane >> 5;
        const int bh = item >> 6, c = item & 63, b = bh >> 2, h = bh & 3, tok0 = b * SEQ + c * 128;
        { const int s = tid & 127, which = tid >> 7; gs[which * 128 + s] = gates[(size_t)(tok0 + s) * 16 + which * 4 + h]; }
#pragma unroll
        for (int i = 0; i < 8; ++i) { const int idx = tid + 512 * i, row = idx >> 5, c16 = idx & 31;
            const v4u v = *(const v4u*)(proj + (size_t)(tok0 + row) * MP + 1024 + h * 256 + c16 * 8);
            *(LAS v4u*)(lds + ML_V + vt16(row, c16, 512)) = v; }
        __syncthreads();
        if (wave < 2) {
            const int dir = wave, s0 = dir ? 127 - 2 * lane : 2 * lane, s1 = dir ? 126 - 2 * lane : 2 * lane + 1;
            const float li0 = gs[dir * 256 + s0], lf0 = gs[dir * 256 + 128 + s0], li1 = gs[dir * 256 + s1], lf1 = gs[dir * 256 + 128 + s1];
            const float pair = lf0 + lf1, inc = wscan_add(pair), exc = inc - pair, b0 = exc + lf0, b1 = inc;
            const float bl = lane63(inc);
            const float a0 = bl - b0 + li0, a1 = bl - b1 + li1;
            const float am = wave_max(fmaxf(a0, a1));
            wv[dir * 128 + s0] = __expf(a0 - am); wv[dir * 128 + s1] = __expf(a1 - am);
            if (lane == 0) { blam[((size_t)(dir * 8 + bh) * 64 + c) * 2] = bl; blam[((size_t)(dir * 8 + bh) * 64 + c) * 2 + 1] = am; }
        }
        __syncthreads();
#pragma unroll
        for (int i = 0; i < 4; ++i) { const int idx = tid + 512 * i, row = idx >> 4, c16 = idx & 15;
            const v4u kv = *(const v4u*)(proj + (size_t)(tok0 + row) * MP + 512 + h * 128 + c16 * 8);
            float f[8]; unpack8(kv, f);
            const float w0 = wv[row], w1 = wv[128 + row];
            v4u a, bb;
            a.x = cvtpk(f[0] * w0, f[1] * w0); a.y = cvtpk(f[2] * w0, f[3] * w0); a.z = cvtpk(f[4] * w0, f[5] * w0); a.w = cvtpk(f[6] * w0, f[7] * w0);
            bb.x = cvtpk(f[0] * w1, f[1] * w1); bb.y = cvtpk(f[2] * w1, f[3] * w1); bb.z = cvtpk(f[4] * w1, f[5] * w1); bb.w = cvtpk(f[6] * w1, f[7] * w1);
            *(LAS v4u*)(lds + ML_A + vt16(row, c16, 256)) = a; *(LAS v4u*)(lds + ML_B + vt16(row, c16, 256)) = bb; }
        __syncthreads();
        if (tid < 256) {
            const int dir = tid >> 7, d = tid & 127; float s = 0.f;
            LAS const unsigned char* kb = lds + (dir ? ML_B : ML_A);
#pragma unroll 8
            for (int r = 0; r < 128; ++r) s += bf2f(*(LAS const unsigned short*)(kb + vt16(r, d >> 3, 256) + (d & 7) * 2));
            nbuf[((size_t)(dir * 8 + bh) * 64 + c) * 128 + d] = s;
        }
        f32x16 af[4], ab[4];
#pragma unroll
        for (int e = 0; e < 4; ++e) { af[e] = (f32x16){}; ab[e] = (f32x16){}; }
        const int q4 = (lane & 15) >> 2, lo8 = 8 * (lane & 1), cq = 2 * ((lane >> 4) & 1) + ((lane & 3) >> 1);
#pragma unroll 2
        for (int ks = 0; ks < 8; ++ks) {
            const int R = 16 * ks + 8 * hh + q4;
            const int cha = 4 * db + cq;
            const bf16x8 Af = cat8(tr_read(lds + ML_A + vt16(R, cha, 256) + lo8), tr_read(lds + ML_A + vt16(R + 4, cha, 256) + lo8));
            const bf16x8 Ab = cat8(tr_read(lds + ML_B + vt16(R, cha, 256) + lo8), tr_read(lds + ML_B + vt16(R + 4, cha, 256) + lo8));
#pragma unroll
            for (int eb = 0; eb < 4; ++eb) {
                const int chv = 4 * (4 * eh + eb) + cq;
                const bf16x8 Bv = cat8(tr_read(lds + ML_V + vt16(R, chv, 512) + lo8), tr_read(lds + ML_V + vt16(R + 4, chv, 512) + lo8));
                af[eb] = __builtin_amdgcn_mfma_f32_32x32x16_bf16(Af, Bv, af[eb], 0, 0, 0);
                ab[eb] = __builtin_amdgcn_mfma_f32_32x32x16_bf16(Ab, Bv, ab[eb], 0, 0, 0);
            }
        }
#pragma unroll
        for (int dir = 0; dir < 2; ++dir) {
            char* ob = (char*)(kvb + ((size_t)(dir * 8 + bh) * 64 + c) * 32768 + (size_t)(db * 8 + 4 * eh) * 1024);
            const unsigned olo = (unsigned)lane * 16u;
#pragma unroll
            for (int eb = 0; eb < 4; ++eb)
#pragma unroll
                for (int k2 = 0; k2 < 2; ++k2) {
                    const f32x16& a = dir ? ab[eb] : af[eb];
                    v4u w; w.x = cvtpk(a[8 * k2 + 0], a[8 * k2 + 1]); w.y = cvtpk(a[8 * k2 + 2], a[8 * k2 + 3]); w.z = cvtpk(a[8 * k2 + 4], a[8 * k2 + 5]); w.w = cvtpk(a[8 * k2 + 6], a[8 * k2 + 7]);
                    *(v4u*)(ob + (unsigned)((eb * 2 + k2) * 1024) + olo) = w;
                }
        }
        __syncthreads();
    }
}

__device__ __forceinline__ void mlstm_scan_phase(bf16* kvb, float* nbuf, const float* blam, float* mprev, int bx, int G, int tid) {
    for (int u = bx; u < 256; u += G) {
        const int seq = u >> 4, slab = u & 15, dir = seq >> 3;
        bf16* base = kvb + (size_t)seq * 64 * 32768 + (size_t)(slab * 512 + tid) * 4;
        const bool do_n = (slab == 0) && (tid < 128);
        float st[4] = {0.f, 0.f, 0.f, 0.f}, nst = 0.f, m = 0.f;
        for (int cc = 0; cc < 64; cc += 8) {
            v2u ld[8]; float nl[8];
#pragma unroll
            for (int k = 0; k < 8; ++k) { const int c = dir ? 63 - (cc + k) : cc + k; ld[k] = *(const v2u*)(base + (size_t)c * 32768); nl[k] = do_n ? nbuf[((size_t)seq * 64 + c) * 128 + tid] : 0.f; }
#pragma unroll
            for (int k = 0; k < 8; ++k) {
                const int c = dir ? 63 - (cc + k) : cc + k;
                const float bl = blam[((size_t)seq * 64 + c) * 2], am = blam[((size_t)seq * 64 + c) * 2 + 1];
                const float mn = fmaxf(bl + m, am), sp = __expf(bl + m - mn), sc = __expf(am - mn);
                v2u o; o.x = cvtpk(st[0], st[1]); o.y = cvtpk(st[2], st[3]);
                *(v2u*)(base + (size_t)c * 32768) = o;
                st[0] = sp * st[0] + sc * __uint_as_float(ld[k].x << 16); st[1] = sp * st[1] + sc * __uint_as_float(ld[k].x & 0xffff0000u);
                st[2] = sp * st[2] + sc * __uint_as_float(ld[k].y << 16); st[3] = sp * st[3] + sc * __uint_as_float(ld[k].y & 0xffff0000u);
                if (do_n) { nbuf[((size_t)seq * 64 + c) * 128 + tid] = nst; nst = sp * nst + sc * nl[k]; }
                if (slab == 0 && tid == 0) mprev[seq * 64 + c] = m;
                m = mn;
            }
        }
    }
}

__device__ __forceinline__ void mlstm_out_phase(const bf16* proj, const float* gates, const bf16* kvb, const float* nbuf, const float* mprev, const float* nw, bf16* hs,
                                                LAS unsigned char* lds, int vcu, int G, int tid) {
    const int wave = __builtin_amdgcn_readfirstlane(tid >> 6), tb = wave & 3, eh = wave >> 2;
    LAS float* gs = (LAS float*)(lds + XTRA_OFF);
    LAS float* ap = gs + 512; LAS float* Mx = gs + 768; LAS float* inr = gs + 1024; LAS float* cl = gs + 1280; LAS float* qnp = gs + 1536; LAS float* npv = gs + 2560;
    for (int item = vcu; item < 512; item += G) {
        int tid_i = tid; asm volatile("" : "+v"(tid_i));
        const int tid = tid_i, lane = tid & 63, r32 = lane & 31, hh = lane >> 5;
        const int bh = item >> 6, c = item & 63, b = bh >> 2, h = bh & 3, tok0 = b * SEQ + c * 128;
        { const int s = tid & 127, which = tid >> 7; gs[which * 128 + s] = gates[(size_t)(tok0 + s) * 16 + which * 4 + h]; }
        if (tid < 256) npv[tid] = nbuf[((size_t)((tid >> 7) * 8 + bh) * 64 + c) * 128 + (tid & 127)];
#pragma unroll
        for (int i = 0; i < 4; ++i) { const int idx = tid + 512 * i, row = idx >> 4, c16 = idx & 15;
            const bf16* src = proj + (size_t)(tok0 + row) * MP + h * 128 + c16 * 8;
            const v4u q = *(const v4u*)src, k = *(const v4u*)(src + 512);
            *(LAS v2u*)(lds + ML_A + qk8(row, 2 * c16)) = (v2u){q.x, q.y}; *(LAS v2u*)(lds + ML_A + qk8(row, 2 * c16 + 1)) = (v2u){q.z, q.w};
            *(LAS v2u*)(lds + ML_B + qk8(row, 2 * c16)) = (v2u){k.x, k.y}; *(LAS v2u*)(lds + ML_B + qk8(row, 2 * c16 + 1)) = (v2u){k.z, k.w}; }
#pragma unroll
        for (int i = 0; i < 8; ++i) { const int idx = tid + 512 * i, row = idx >> 5, c16 = idx & 31;
            const v4u v = *(const v4u*)(proj + (size_t)(tok0 + row) * MP + 1024 + h * 256 + c16 * 8);
            *(LAS v4u*)(lds + ML_V + vt16(row, c16, 512)) = v; }
        __syncthreads();
        if (wave < 2) {
            const int dir = wave, s0 = dir ? 127 - 2 * lane : 2 * lane, s1 = dir ? 126 - 2 * lane : 2 * lane + 1;
            const float li0 = gs[dir * 256 + s0], lf0 = gs[dir * 256 + 128 + s0], li1 = gs[dir * 256 + s1], lf1 = gs[dir * 256 + 128 + s1];
            const float pair = lf0 + lf1, inc = wscan_add(pair), exc = inc - pair, b0 = exc + lf0, b1 = inc;
            const float ap0 = li0 - b0, ap1 = li1 - b1;
            const float incm = wscan_max(fmaxf(ap0, ap1));
            const float excm = wave_shr1(incm, -INFINITY);
            const float pm0 = fmaxf(excm, ap0), pm1 = incm;
            const float mp = mprev[(dir * 8 + bh) * 64 + c];
            const float M0 = fmaxf(mp, pm0), M1 = fmaxf(mp, pm1);
            ap[dir * 128 + s0] = ap0; ap[dir * 128 + s1] = ap1;
            Mx[dir * 128 + s0] = M0; Mx[dir * 128 + s1] = M1;
            inr[dir * 128 + s0] = __expf(mp - M0); inr[dir * 128 + s1] = __expf(mp - M1);
            cl[dir * 128 + s0] = __expf(-(b0 + M0)); cl[dir * 128 + s1] = __expf(-(b1 + M1));
        }
        {
            const int t = tid & 127, qt = tid >> 7; float s0 = 0.f, s1 = 0.f;
#pragma unroll
            for (int g8 = 0; g8 < 8; ++g8) {
                const v2u w = *(LAS const v2u*)(lds + ML_A + qk8(t, 8 * qt + g8));
                const int d = 32 * qt + 4 * g8;
                const float q0 = __uint_as_float(w.x << 16), q1 = __uint_as_float(w.x & 0xffff0000u), q2 = __uint_as_float(w.y << 16), q3 = __uint_as_float(w.y & 0xffff0000u);
                s0 += q0 * npv[d] + q1 * npv[d + 1] + q2 * npv[d + 2] + q3 * npv[d + 3];
                s1 += q0 * npv[128 + d] + q1 * npv[128 + d + 1] + q2 * npv[128 + d + 2] + q3 * npv[128 + d + 3];
            }
            qnp[(qt * 2 + 0) * 128 + t] = s0; qnp[(qt * 2 + 1) * 128 + t] = s1;
        }
        __syncthreads();
        bf16x8 qf[8];
#pragma unroll
        for (int ks = 0; ks < 8; ++ks) {
            const v2u lo = *(LAS const v2u*)(lds + ML_A + qk8(32 * tb + r32, 4 * ks + hh)), hi = *(LAS const v2u*)(lds + ML_A + qk8(32 * tb + r32, 4 * ks + 2 + hh));
            qf[ks] = __builtin_bit_cast(bf16x8, (v4u){lo.x, lo.y, hi.x, hi.y});
        }
        const int q4 = (lane & 15) >> 2, lo8 = 8 * (lane & 1), cq = 2 * ((lane >> 4) & 1) + ((lane & 3) >> 1);
        const int tl = 32 * tb + r32;
        bf16x8 pa[5][2]; float rs0 = 0.f, rs1 = 0.f;
#pragma unroll
        for (int i = 0; i < 5; ++i) {
            const int dir = (i > tb) ? 1 : 0, sb = i - dir;
            f32x16 x = (f32x16){};
#pragma unroll
            for (int ks = 0; ks < 8; ++ks) {
                const v2u lo = *(LAS const v2u*)(lds + ML_B + qk8(32 * sb + r32, 4 * ks + hh)), hi = *(LAS const v2u*)(lds + ML_B + qk8(32 * sb + r32, 4 * ks + 2 + hh));
                x = __builtin_amdgcn_mfma_f32_32x32x16_bf16(__builtin_bit_cast(bf16x8, (v4u){lo.x, lo.y, hi.x, hi.y}), qf[ks], x, 0, 0, 0);
            }
            const float Mt = Mx[dir * 128 + tl];
            float rsum = 0.f;
#pragma unroll
            for (int r = 0; r < 16; ++r) {
                const int sl = 32 * sb + crow(r, hh);
                const bool ok = dir ? (sl >= tl) : (sl <= tl);
                const float p = ok ? x[r] * __expf(ap[dir * 128 + sl] - Mt) : 0.f;
                x[r] = p; rsum += p;
            }
            if (dir) rs1 += rsum; else rs0 += rsum;
#pragma unroll
            for (int s2 = 0; s2 < 2; ++s2) { v4u w; w.x = cvtpk(x[8 * s2 + 0], x[8 * s2 + 1]); w.y = cvtpk(x[8 * s2 + 2], x[8 * s2 + 3]); w.z = cvtpk(x[8 * s2 + 4], x[8 * s2 + 5]); w.w = cvtpk(x[8 * s2 + 6], x[8 * s2 + 7]); pa[i][s2] = __builtin_bit_cast(bf16x8, w); }
        }
        rs0 = xhalf_sum(rs0); rs1 = xhalf_sum(rs1);
        float rd0, rd1, qs0, qs1;
        { const float qn0 = (qnp[0 * 128 + tl] + qnp[2 * 128 + tl]) + (qnp[4 * 128 + tl] + qnp[6 * 128 + tl]);
          const float qn1 = (qnp[1 * 128 + tl] + qnp[3 * 128 + tl]) + (qnp[5 * 128 + tl] + qnp[7 * 128 + tl]);
          const float in0 = inr[tl], in1 = inr[128 + tl];
          rd0 = 1.0f / fmaxf(fabsf(rs0 + in0 * qn0), cl[tl]); rd1 = 1.0f / fmaxf(fabsf(rs1 + in1 * qn1), cl[128 + tl]);
          qs0 = in0 * rd0; qs1 = in1 * rd1; }
#pragma unroll
        for (int i = 0; i < 5; ++i) {
            const float rd = (i > tb) ? rd1 : rd0;
#pragma unroll
            for (int s2 = 0; s2 < 2; ++s2) { float f[8]; unpack8(__builtin_bit_cast(v4u, pa[i][s2]), f);
                v4u w; w.x = cvtpk(f[0] * rd, f[1] * rd); w.y = cvtpk(f[2] * rd, f[3] * rd); w.z = cvtpk(f[4] * rd, f[5] * rd); w.w = cvtpk(f[6] * rd, f[7] * rd); pa[i][s2] = __builtin_bit_cast(bf16x8, w); }
        }
        f32x16 acc[4];
#pragma unroll
        for (int e = 0; e < 4; ++e) acc[e] = (f32x16){};
#pragma unroll
        for (int i = 0; i < 5; ++i) {
            const int sb = i - ((i > tb) ? 1 : 0);
#pragma unroll
            for (int s2 = 0; s2 < 2; ++s2)
#pragma unroll
                for (int eb = 0; eb < 4; ++eb) {
                    const int R0 = 32 * sb + 16 * s2 + 4 * hh + q4, chv = 4 * (4 * eh + eb) + cq;
                    const bf16x8 vf = cat8(tr_read(lds + ML_V + vt16(R0, chv, 512) + lo8), tr_read(lds + ML_V + vt16(R0 + 8, chv, 512) + lo8));
                    acc[eb] = __builtin_amdgcn_mfma_f32_32x32x16_bf16(pa[i][s2], vf, acc[eb], 0, 0, 0);
                }
        }
        {
            const char* cb0 = (const char*)(kvb + ((size_t)(0 * 8 + bh) * 64 + c) * 32768 + (size_t)eh * 4096);
            const char* cb1 = (const char*)(kvb + ((size_t)(1 * 8 + bh) * 64 + c) * 32768 + (size_t)eh * 4096);
            const unsigned clo = (unsigned)lane * 16u;
            constexpr int NSET = 5;
            bf16x8 cf[NSET][4];
#define ML_LOADC(ix_, dst) _Pragma("unroll") for (int eb = 0; eb < 4; ++eb) dst[eb] = *(const bf16x8*)((((ix_) >> 3) ? cb1 : cb0) + (unsigned)((((((ix_) & 7) >> 1) * 8 + eb) * 2 + ((ix_) & 1)) * 1024) + clo)
#pragma unroll
            for (int p = 0; p < NSET - 1; ++p) { ML_LOADC(p, cf[p]); }
#pragma unroll
            for (int ix = 0; ix < 16; ++ix) {
                if (ix + NSET - 1 < 16) { ML_LOADC(ix + NSET - 1, cf[(ix + NSET - 1) % NSET]); }
                const float qsc = (ix >> 3) ? qs1 : qs0;
                float f[8]; unpack8(__builtin_bit_cast(v4u, qf[ix & 7]), f);
                v4u w; w.x = cvtpk(f[0] * qsc, f[1] * qsc); w.y = cvtpk(f[2] * qsc, f[3] * qsc); w.z = cvtpk(f[4] * qsc, f[5] * qsc); w.w = cvtpk(f[6] * qsc, f[7] * qsc);
                const bf16x8 qsv = __builtin_bit_cast(bf16x8, w);
                __builtin_amdgcn_sched_barrier(0);
#pragma unroll
                for (int eb = 0; eb < 4; ++eb) acc[eb] = __builtin_amdgcn_mfma_f32_32x32x16_bf16(qsv, cf[ix % NSET][eb], acc[eb], 0, 0, 0);
                __builtin_amdgcn_sched_barrier(0);
            }
#undef ML_LOADC
        }
        v2u ogr[16];
#pragma unroll
        for (int rr = 0; rr < 16; ++rr) ogr[rr] = *(const v2u*)(proj + (size_t)(tok0 + 16 * wave + rr) * MP + 2048 + h * 256 + lane * 4);
        const f32x4 w4 = *(const f32x4*)(nw + h * 256 + lane * 4);
        __syncthreads();
#pragma unroll
        for (int e = 0; e < 4; ++e)
#pragma unroll
            for (int r = 0; r < 16; ++r) *(LAS float*)(lds + (32 * tb + crow(r, hh)) * 1024 + (128 * eh + 32 * e + r32) * 4) = acc[e][r];
        __syncthreads();
#pragma unroll
        for (int rr = 0; rr < 16; ++rr) {
            const int t = 16 * wave + rr;
            const f32x4 v = *(LAS const f32x4*)(lds + t * 1024 + lane * 16);
            const float ss = wave_sum((v.x * v.x + v.y * v.y) + (v.z * v.z + v.w * v.w));
            const float rn = rsqrtf(ss * (1.0f / 256.0f) + EPS);
            const v2u og = ogr[rr];
            const float o0 = __uint_as_float(og.x << 16), o1 = __uint_as_float(og.x & 0xffff0000u), o2 = __uint_as_float(og.y << 16), o3 = __uint_as_float(og.y & 0xffff0000u);
            v2u out;
            out.x = cvtpk(v.x * rn * w4.x / (1.0f + __expf(-o0)), v.y * rn * w4.y / (1.0f + __expf(-o1)));
            out.y = cvtpk(v.z * rn * w4.z / (1.0f + __expf(-o2)), v.w * rn * w4.w / (1.0f + __expf(-o3)));
            *(v2u*)(hs + (size_t)(tok0 + t) * D + h * 256 + lane * 4) = out;
        }
        __syncthreads();
    }
}

#ifndef OPT_ATTN
#define OPT_ATTN 1
#endif
#ifndef OPT_MLSTM
#define OPT_MLSTM 1
#endif
#ifndef PROBE_DUP
#define PROBE_DUP 0
#endif
#ifndef ONE_LAUNCH
#define ONE_LAUNCH 1
#endif
typedef unsigned v2u_t __attribute__((ext_vector_type(2)));
__global__ void __launch_bounds__(NWAVES * 64, 2) mk_fwd(Args args) {
    extern __shared__ __attribute__((aligned(16))) unsigned char lds_raw[];
    LAS unsigned char* lds = (LAS unsigned char*)lds_raw;
    volatile LAS unsigned* MISC = (volatile LAS unsigned*)(lds + MISC_OFF);
    const int tid = threadIdx.x; const int wave_s = __builtin_amdgcn_readfirstlane(tid >> 6);
    const int G = gridDim.x; const int bx = blockIdx.x; const int vcu = (G % 8 == 0) ? (bx % 8) * (G / 8) + bx / 8 : bx;
    Ptrs P;
    P.x = args.in[0]; P.pos = (const int*)args.in[1]; P.norm_mix_w = args.in[2]; P.norm_ffn_w = args.in[3]; P.norm_final_w = args.in[4]; P.mlstm_w_in = args.in[5];
    P.mlstm_b_gate = args.in[6]; P.mlstm_norm_w = args.in[7]; P.mlstm_w_out = args.in[8]; P.attn_w_in = args.in[9]; P.attn_sink = args.in[10]; P.attn_w_out = args.in[11];
    P.ffn_w_in = args.in[12]; P.ffn_w_out = args.in[13]; P.out = args.out; P.ws = args.ws;
    unsigned char* ws = args.ws;
    gu32* ctl = (gu32*)(ws + WS_CTL);
    for (int u = tid; u < (LDS_BYTES - LDSCTL_OFF) / 4; u += NWAVES * 64) ((LAS unsigned*)(lds + LDSCTL_OFF))[u] = 0u;
    __syncthreads();
    const int lo = args.ph_lo, hi = args.ph_hi;
    XcdBarrier bar; bar.bar = (unsigned*)(ctl + CW_BAR); bar.x = 0; bar.st = nullptr;
    if (hi - lo > 1) bar = xcd_barrier_post((unsigned*)(ctl + CW_BAR), MISC + 8);
    int ph = 0;
#define PH_ON (ph >= lo && ph < hi)
#define PH_IDS int tid_p; asm volatile("v_mbcnt_lo_u32_b32 %0, -1, 0\n\tv_mbcnt_hi_u32_b32 %0, -1, %0" : "=v"(tid_p)); tid_p += wave_s * 64; asm volatile("" : "+v"(tid_p)); const int lane = tid_p & 63, wave = __builtin_amdgcn_readfirstlane(tid_p >> 6); (void)lane; (void)wave
#define REP(bit) for (int rep_ = 0; rep_ < 1 + ((args.dup >> (bit)) & 1); ++rep_)
#define PH_END do { if (ph >= lo && ph + 1 < hi) xcd_barrier(bar); ++ph; } while (0)

    bf16* xb = (bf16*)(ws + WS_XB); bf16* hs = (bf16*)(ws + WS_HS); bf16* proj = (bf16*)(ws + WS_PROJ);
    float* part = (float*)(ws + WS_PART);
    const float* cosT = (const float*)(ws + WS_ROPE); const float* sinT = cosT + (size_t)M * 32;

    if (PH_ON) REP(4) { PH_IDS; p0_prologue(P, lds, vcu, G, wave, lane); }
    PH_END;
#if PROBE_DUP & 64
    if (hi - lo > 1) for (int xb_ = 0; xb_ < 10; ++xb_) xcd_barrier(bar);
#endif

    for (int L = 0; L < 4; ++L) {
        const int j = L >> 1;
        if ((L & 1) == 0) {
            if (PH_ON) {
                { PH_IDS; for (int gb = bx; gb < M / 64; gb += G) gates_step(P, j, lds, gb, wave, lane); }
                pg8::Gemm g{xb, (const bf16*)(ws + W_MIN) + (size_t)j * MP * D, M, MP, D}; pg8::StaticOrder S; S.init(M, MP, G, bx);
                pg8::EpiProj<false> E{proj, MP, part, nullptr, nullptr};
                REP(1) pg8::gemm_phase<pg8::EpiProj<false>, pg8::StaticOrder, true, true>(lds + RING_OFF, g, S, E, wave_s);
            }
            PH_END;
            if (PH_ON) REP(2) { PH_IDS; mlstm_chunk_phase(proj, (const float*)(ws + WS_GATES), (bf16*)(ws + WS_KV), (float*)(ws + WS_NBUF), (float*)(ws + WS_SMALL), lds, vcu, G, tid_p); }
            PH_END;
            if (PH_ON) { PH_IDS; mlstm_scan_phase((bf16*)(ws + WS_KV), (float*)(ws + WS_NBUF), (const float*)(ws + WS_SMALL), (float*)(ws + WS_SMALL + 16384), bx, G, tid_p); }
            PH_END;
            if (PH_ON) REP(5) { PH_IDS; mlstm_out_phase(proj, (const float*)(ws + WS_GATES), (const bf16*)(ws + WS_KV), (const float*)(ws + WS_NBUF), (const float*)(ws + WS_SMALL + 16384), P.mlstm_norm_w + j * D, hs, lds, vcu, G, tid_p); }
            PH_END;
        } else {
            if (PH_ON) {
                pg8::Gemm g{xb, (const bf16*)(ws + W_AIN) + (size_t)j * AW * D, M, AW, D}; pg8::StaticOrder S; S.init(M, AW, G, bx);
                pg8::EpiProj<true> E{proj, AW, part, cosT, sinT};
                REP(1) pg8::gemm_phase<pg8::EpiProj<true>, pg8::StaticOrder, true, true>(lds + RING_OFF, g, S, E, wave_s);
            }
            PH_END;
            if (PH_ON) REP(3) { PH_IDS; attn_phase(proj, P.attn_sink + j * 16, hs, lds, vcu, G, tid_p); }
            PH_END;
        }
        if (PH_ON) {
            const bf16* wo = (L & 1) ? (const bf16*)(ws + W_AOUT) + (size_t)j * D * D : (const bf16*)(ws + W_MOUT) + (size_t)j * D * D;
            pg8::Gemm g{hs, wo, M, D, D}; pg8::StaticOrder S; S.init(M, D, G, bx);
#if PROBE_DUP & 256
            { pg8::EpiNull EN; pg8::gemm_phase<pg8::EpiNull, pg8::StaticOrder, true, true>(lds + RING_OFF, g, S, EN, wave_s); }
#endif
            pg8::EpiResid E{xb, part};
            pg8::gemm_phase<pg8::EpiResid, pg8::StaticOrder, true, true>(lds + RING_OFF, g, S, E, wave_s);
        }
        PH_END;
        if (PH_ON) {
            pg8::Gemm g{xb, (const bf16*)(ws + W_FIN) + (size_t)L * 2 * DFF * D, M, 2 * DFF, D}; pg8::StaticOrder S; S.init(M, 2 * DFF, G, bx);
            pg8::EpiSwiGLU E{proj, DFF, part};
            REP(0) pg8::gemm_phase<pg8::EpiSwiGLU, pg8::StaticOrder, true, true>(lds + RING_OFF, g, S, E, wave_s);
        }
        PH_END;
        if (PH_ON) {
            pg8::Gemm g{proj, (const bf16*)(ws + W_FOUT) + (size_t)L * D * DFF, M, D, DFF}; pg8::StaticOrder S; S.init(M, D, G, bx);
#if PROBE_DUP & 128
            { pg8::EpiNull EN; pg8::gemm_phase<pg8::EpiNull, pg8::StaticOrder, true, true>(lds + RING_OFF, g, S, EN, wave_s); }
#endif
            pg8::EpiResid E{xb, part};
            pg8::gemm_phase<pg8::EpiResid, pg8::StaticOrder, true, true>(lds + RING_OFF, g, S, E, wave_s);
        }
        PH_END;
    }
    if (PH_ON) {
        PH_IDS;
        const int gw = vcu * NWAVES + wave, NGW = G * NWAVES;
        for (int m = gw; m < M; m += NGW) {
            float s = lane < 16 ? part[(size_t)m * 16 + lane] : 0.f;
            s = wave_sum(s);
            const float rstd = rsqrtf(s * (1.0f / 1024.0f) + EPS);
            GAS f32x4* orow = (GAS f32x4*)(P.out + (size_t)m * D) + lane;
            const GAS f32x4* wr = (const GAS f32x4*)P.norm_final_w + lane;
            const GAS v2u_t* xr = (const GAS v2u_t*)(xb + (size_t)m * D) + lane;
#pragma unroll
            for (int jj = 0; jj < 4; ++jj) { const v2u_t xv = xr[64 * jj]; const f32x4 w = wr[64 * jj];
                f32x4 v = {__uint_as_float(xv.x << 16), __uint_as_float(xv.x & 0xffff0000u), __uint_as_float(xv.y << 16), __uint_as_float(xv.y & 0xffff0000u)};
                v = v * rstd * w; orow[64 * jj] = v; }
        }
    }
    PH_END;
}

namespace nv {
constexpr int TCH = 32;
__global__ void __launch_bounds__(272) k_mlstm_rec(const bf16* __restrict__ proj, const float* __restrict__ gates, bf16* __restrict__ hf, bf16* __restrict__ hb) {
    __shared__ float sq[TCH][128], sk[TCH][128], sv[TCH][17], sli[TCH], slf[TCH];
    __shared__ float red[2][16][17];
    const int es = blockIdx.x, h = blockIdx.y, b = blockIdx.z >> 1, dir = blockIdx.z & 1;
    const int tid = threadIdx.x, e = tid % 17, dg = tid / 17;
    float C[8];
#pragma unroll
    for (int j = 0; j < 8; ++j) C[j] = 0.f;
    float m = 0.f;
    bf16* hout = dir ? hb : hf;
    int par = 0;
    for (int c0 = 0; c0 < SEQ; c0 += TCH) {
        __syncthreads();
        for (int i = tid; i < TCH * 128; i += 272) {
            const int tt = i >> 7, d = i & 127;
            const int t = dir ? (SEQ - 1 - (c0 + tt)) : (c0 + tt);
            const bf16* row = proj + (size_t)(b * SEQ + t) * MP;
            sq[tt][d] = bf2f(row[h * 128 + d]);
            sk[tt][d] = bf2f(row[512 + h * 128 + d]);
        }
        for (int i = tid; i < TCH * 17; i += 272) {
            const int tt = i / 17, ee = i % 17;
            const int t = dir ? (SEQ - 1 - (c0 + tt)) : (c0 + tt);
            const bf16* row = proj + (size_t)(b * SEQ + t) * MP;
            sv[tt][ee] = ee < 16 ? bf2f(row[1024 + h * 256 + es * 16 + ee]) : 1.0f;
        }
        if (tid < TCH) {
            const int t = dir ? (SEQ - 1 - (c0 + tid)) : (c0 + tid);
            const float* row = gates + (size_t)(b * SEQ + t) * 16;
            sli[tid] = row[(dir ? 8 : 0) + h];
            slf[tid] = row[(dir ? 12 : 4) + h];
        }
        __syncthreads();
        for (int tt = 0; tt < TCH; ++tt) {
            const float li = sli[tt], lf = slf[tt];
            const float mn = fmaxf(lf + m, li);
            const float fs = expf(lf + m - mn), is = expf(li - mn);
            m = mn;
            const float vv = sv[tt][e] * is;
            float partv = 0.f;
#pragma unroll
            for (int j = 0; j < 8; ++j) {
                const int d = dg * 8 + j;
                C[j] = fs * C[j] + sk[tt][d] * vv;
                partv += sq[tt][d] * C[j];
            }
            red[par][dg][e] = partv;
            __syncthreads();
            if (tid < 16) {
                float num = 0.f, qn = 0.f;
#pragma unroll
                for (int g = 0; g < 16; ++g) { num += red[par][g][tid]; qn += red[par][g][16]; }
                const float den = fmaxf(fabsf(qn), expf(-m));
                const int t = dir ? (SEQ - 1 - (c0 + tt)) : (c0 + tt);
                hout[(size_t)(b * SEQ + t) * D + h * 256 + es * 16 + tid] = (bf16)f2bf(num / den);
            }
            par ^= 1;
        }
    }
}
__global__ void k_mlstm_post(const bf16* __restrict__ hf, const bf16* __restrict__ hb, const bf16* __restrict__ proj, const float* __restrict__ nw, bf16* __restrict__ out) {
    const int row = blockIdx.x, tid = threadIdx.x, h = tid >> 6, lane = tid & 63;
    const size_t off = (size_t)row * D + h * 256 + lane * 4;
    float v[4]; float s = 0.f;
#pragma unroll
    for (int c = 0; c < 4; ++c) { v[c] = bf2f(hf[off + c]) + bf2f(hb[off + c]); s += v[c] * v[c]; }
    for (int o = 32; o > 0; o >>= 1) s += __shfl_xor(s, o);
    const float r = rsqrtf(s * (1.0f / 256.0f) + EPS);
#pragma unroll
    for (int c = 0; c < 4; ++c) {
        const float og = bf2f(proj[(size_t)row * MP + 2048 + h * 256 + lane * 4 + c]);
        out[off + c] = (bf16)f2bf(v[c] * r * nw[h * 256 + lane * 4 + c] / (1.0f + expf(-og)));
    }
}
__global__ void __launch_bounds__(64) k_attn(const bf16* __restrict__ proj, const float* __restrict__ sink, bf16* __restrict__ out) {
    const int idx = blockIdx.x * 64 + threadIdx.x;
    const int hq = idx / M, tok = idx % M;
    const int b = tok / SEQ, i = tok % SEQ, hkv = hq >> 2;
    float q[64], acc[64];
    const bf16* qp = proj + (size_t)tok * AW + hq * 64;
#pragma unroll
    for (int d = 0; d < 64; ++d) { q[d] = bf2f(qp[d]); acc[d] = 0.f; }
    float m = sink[hq], l = 1.0f;
    const int j0 = max(0, i - 128), j1 = min(SEQ - 1, i + 128);
    for (int jx = j0; jx <= j1; ++jx) {
        const bf16* kp = proj + (size_t)(b * SEQ + jx) * AW + 1024 + hkv * 64;
        const bf16* vp = kp + 256;
        float s = 0.f;
#pragma unroll
        for (int d = 0; d < 64; ++d) s += q[d] * bf2f(kp[d]);
        if (s > m) {
            const float f = expf(m - s);
            l *= f;
#pragma unroll
            for (int d = 0; d < 64; ++d) acc[d] *= f;
            m = s;
        }
        const float p = expf(s - m);
        l += p;
#pragma unroll
        for (int d = 0; d < 64; ++d) acc[d] += p * bf2f(vp[d]);
    }
    const float rl = 1.0f / l;
    bf16* op = out + (size_t)tok * D + hq * 64;
#pragma unroll
    for (int d = 0; d < 64; ++d) op[d] = (bf16)f2bf(acc[d] * rl);
}
}

extern "C" void kernel_launch(void* const* d_in, const int* in_sizes, int n_in, void* d_out, int out_size, void* d_ws, size_t ws_size, hipStream_t stream) {
    static int grid = 0;
    if (grid == 0) {
        int dev = 0, cus = 0;
        if (hipGetDevice(&dev) != hipSuccess || hipDeviceGetAttribute(&cus, hipDeviceAttributeMultiprocessorCount, dev) != hipSuccess) { fprintf(stderr, "kernel_launch: device query failed\n"); grid = -1; return; }
        if (hipFuncSetAttribute((const void*)mk_fwd, hipFuncAttributeMaxDynamicSharedMemorySize, LDS_BYTES) != hipSuccess) { fprintf(stderr, "kernel_launch: hipFuncSetAttribute failed\n"); grid = -1; return; }
        if (ws_size < WS_END) { fprintf(stderr, "kernel_launch: workspace too small: %zu < %zu\n", ws_size, (size_t)WS_END); grid = -1; return; }
        (void)hipGetLastError();
        grid = cus;
    }
    if (grid < 0) return;
    (void)hipMemsetAsync((char*)d_ws + WS_CTL, 0, CTL_ZERO_BYTES, stream);
    Args a{};
    for (int i = 0; i < 14; ++i) a.in[i] = (const float*)d_in[i];
    a.out = (float*)d_out; a.ws = (unsigned char*)d_ws; a.dup = PROBE_DUP;
    unsigned char* ws = (unsigned char*)d_ws;
    int ph = 0;
    auto launch = [&](int lo, int hi) { a.ph_lo = lo; a.ph_hi = hi; hipLaunchKernelGGL(mk_fwd, dim3(grid), dim3(NWAVES * 64), LDS_BYTES, stream, a); };
#if ONE_LAUNCH
    launch(0, 1000);
#else
    launch(ph, ph + 1); ++ph;
    for (int L = 0; L < 4; ++L) {
        const int j = L >> 1;
        launch(ph, ph + 1); ++ph;
        if ((L & 1) == 0) {
#if OPT_MLSTM
            launch(ph, ph + 1); launch(ph + 1, ph + 2); launch(ph + 2, ph + 3);
#else
            bf16* hf = (bf16*)(ws + WS_KV); bf16* hb = hf + (size_t)M * D;
            hipLaunchKernelGGL(nv::k_mlstm_rec, dim3(16, 4, 4), dim3(272), 0, stream, (const bf16*)(ws + WS_PROJ), (const float*)(ws + WS_GATES), hf, hb);
            hipLaunchKernelGGL(nv::k_mlstm_post, dim3(M), dim3(256), 0, stream, (const bf16*)hf, (const bf16*)hb, (const bf16*)(ws + WS_PROJ), (const float*)d_in[7] + j * D, (bf16*)(ws + WS_HS));
#endif
            ph += 3;
        } else {
#if OPT_ATTN
            launch(ph, ph + 1);
#else
            hipLaunchKernelGGL(nv::k_attn, dim3(M * 16 / 64), dim3(64), 0, stream, (const bf16*)(ws + WS_PROJ), (const float*)d_in[10] + j * 16, (bf16*)(ws + WS_HS));
#endif
            ph += 1;
        }
        launch(ph, ph + 1); ++ph;
        launch(ph, ph + 1); ++ph;
        launch(ph, ph + 1); ++ph;
    }
    launch(ph, ph + 1); ++ph;
#endif
}
```

```cpp
#include <hip/hip_runtime.h>
#include <cstdio>
#include <cstdint>
#include <cmath>
namespace pg8 {
#define PG8_LAS __attribute__((address_space(3)))
typedef unsigned short bf16_t;
typedef short bf16x8 __attribute__((ext_vector_type(8)));
typedef float f32x4 __attribute__((ext_vector_type(4)));
typedef unsigned u32x4 __attribute__((ext_vector_type(4)));
constexpr int BM = 256, BK = 64, HALF = 128, HTB = HALF * BK * 2  , STAGE_BYTES = 8 * HTB, NXCD = 8, WGM = 8;

__host__ __device__ __forceinline__ int lds_byte(int r, int c) { const int st = (r >> 4) * 2 + (c >> 5), rr = r & 15, cc = c & 31, ob = rr * 64 + cc * 2; return st * 1024 + (ob ^ (((ob >> 9) & 1) << 5)); }
__host__ __device__ __forceinline__ void stage_rc(int b, int& R, int& C) { const int st = b / 1024, sb = b % 1024, swz = sb ^ (((sb >> 9) & 1) << 5); R = (st >> 1) * 16 + swz / 64; C = (st & 1) * 32 + (swz % 64) / 2; }
__host__ __device__ __forceinline__ int perm32(int rho) { const int n = rho >> 4, i = rho & 15; return 8 * (i >> 2) + 4 * n + (i & 3); }

struct Unit { int pm, pn, ord; };
struct Gemm { const bf16_t* A; const bf16_t* Bt; int M, N, K; };

struct StaticOrder {
    int nM, nN, nwg, G, c;
    __host__ __device__ void init(int M, int N, int G_, int c_) { nM = M / BM; nN = N / BM; nwg = nM * nN; G = G_; c = c_; }
    __host__ __device__ bool next(int i, Unit& u) const {
        const long L = (long)i * G + c; if (L >= nwg) return false;
        int wgid = (int)L; { const int q = nwg / NXCD, r = nwg % NXCD, xcd = wgid % NXCD, off = wgid / NXCD; wgid = (xcd < r ? xcd * (q + 1) : r * (q + 1) + (xcd - r) * q) + off; }
        const int nig = WGM * nN, gid = wgid / nig, fm = gid * WGM, gsz = (nM - fm) < WGM ? (nM - fm) : WGM;
        u.pm = fm + ((wgid % nig) % gsz); u.pn = (wgid % nig) / gsz; u.ord = i; return true;
    }
    __device__ __forceinline__ void a_ready(const Unit&) const {}
    __device__ __forceinline__ void done(const Unit&) const {}
};

__device__ __forceinline__ unsigned cvt_pk_bf16(float lo, float hi) { unsigned r; asm volatile("v_cvt_pk_bf16_f32 %0, %1, %2" : "=v"(r) : "v"(lo), "v"(hi)); return r; }
typedef float f32x2 __attribute__((ext_vector_type(2)));

constexpr int EP_M = 16384;
constexpr float EP_EPS = 1e-6f;
typedef unsigned u32x2 __attribute__((ext_vector_type(2)));

template <int K> __device__ __forceinline__ float shx(float v) { static_assert(K == 1 || K == 2 || K == 4 || K == 8 || K == 16, "xor mask"); return __int_as_float(__builtin_amdgcn_ds_swizzle(__float_as_int(v), 0x1F | (K << 10))); }
__device__ __forceinline__ float xhalf_sum(float v) { auto rr = __builtin_amdgcn_permlane32_swap(__float_as_uint(v), __float_as_uint(v), false, false); return __uint_as_float(rr[0]) + __uint_as_float(rr[1]); }
__device__ __forceinline__ float xhalf_max(float v) { auto rr = __builtin_amdgcn_permlane32_swap(__float_as_uint(v), __float_as_uint(v), false, false); return fmaxf(__uint_as_float(rr[0]), __uint_as_float(rr[1])); }
__device__ __forceinline__ void row_rstd(const PG8_LAS float* rtab, const Unit& u, int wr, int fr, float (&rs)[2][4]) {
#pragma unroll
    for (int ai = 0; ai < 2; ++ai)
#pragma unroll
        for (int m = 0; m < 4; ++m) rs[ai][m] = rtab[u.ord * 256 + wr * 64 + ai * HALF + m * 16 + fr];
}
template <class Sched> __device__ __forceinline__ void rstd_table_fill(const float* part, const Sched& S, PG8_LAS float* rtab, int tid) {
    Unit u;
    for (int i0 = 0; S.next(i0, u); i0 += 2) {
        const int i = i0 + (tid >> 8);
        if (S.next(i, u)) {
            const int r = tid & 255; const f32x4* p = (const f32x4*)(part + (size_t)(u.pm * BM + r) * 16);
            const f32x4 a = p[0], b = p[1], c = p[2], d = p[3];
            const float s = ((a[0] + a[1]) + (a[2] + a[3])) + ((b[0] + b[1]) + (b[2] + b[3])) + ((c[0] + c[1]) + (c[2] + c[3])) + ((d[0] + d[1]) + (d[2] + d[3]));
            rtab[i * 256 + r] = rsqrtf(s * (1.0f / 1024.0f) + EP_EPS);
        }
    }
    __syncthreads();
}
template <bool ROPE> struct EpiProj {
    static constexpr bool PERM = true, AFTER_DRAIN = false;
    bf16_t* O; int ldc; const PG8_LAS float* rtab; const float* cosT; const float* sinT;
    __device__ __forceinline__ void operator()(const f32x4 (&acc)[2][2][4][2], const Unit& u, int wr, int wc, int fr, int fq) const {
        const int row0 = u.pm * BM + wr * 64 + fr;
        float rs[2][4]; row_rstd(rtab, u, wr, fr, rs);
        const int col0 = u.pn * BM + wc * 32 + 8 * fq;
        const int i0 = (wc & 1) * 16 + 4 * fq;
        const bool rope = ROPE && (u.pn < 5);
#pragma unroll
        for (int ai = 0; ai < 2; ++ai)
#pragma unroll
            for (int m = 0; m < 4; ++m) {
                const int row = row0 + ai * HALF + m * 16;
                bf16_t* rowp = (bf16_t*)((char*)O + ((unsigned)row * (unsigned)ldc + (unsigned)col0) * 2u);
                const float r = rs[ai][m];
                f32x4 cs = {1.f, 1.f, 1.f, 1.f}, sn = {0.f, 0.f, 0.f, 0.f};
                if (rope) { const unsigned to = ((unsigned)row * 32u + (unsigned)i0) * 4u; cs = *(const f32x4*)((const char*)cosT + to); sn = *(const f32x4*)((const char*)sinT + to); }
#pragma unroll
                for (int bj = 0; bj < 2; ++bj) {
                    f32x4 v0 = acc[ai][bj][m][0] * r, v1 = acc[ai][bj][m][1] * r;
                    if (ROPE) {
                        const f32x4 a = v0, b = v1;
                        v0[0] = a[0] * cs[0] - a[1] * sn[0]; v0[1] = a[1] * cs[0] + a[0] * sn[0];
                        v0[2] = a[2] * cs[1] - a[3] * sn[1]; v0[3] = a[3] * cs[1] + a[2] * sn[1];
                        v1[0] = b[0] * cs[2] - b[1] * sn[2]; v1[1] = b[1] * cs[2] + b[0] * sn[2];
                        v1[2] = b[2] * cs[3] - b[3] * sn[3]; v1[3] = b[3] * cs[3] + b[2] * sn[3];
                    }
                    u32x4 w; w.x = cvt_pk_bf16(v0[0], v0[1]); w.y = cvt_pk_bf16(v0[2], v0[3]); w.z = cvt_pk_bf16(v1[0], v1[1]); w.w = cvt_pk_bf16(v1[2], v1[3]);
                    *(u32x4*)(rowp + bj * HALF) = w;
                }
            }
    }
};
struct EpiSwiGLU {
    static constexpr bool PERM = true, AFTER_DRAIN = false;
    bf16_t* O; int ldc; const PG8_LAS float* rtab;
    __device__ __forceinline__ void operator()(const f32x4 (&acc)[2][2][4][2], const Unit& u, int wr, int wc, int fr, int fq) const {
        const int row0 = u.pm * BM + wr * 64 + fr;
        float rs[2][4];
        if (rtab) row_rstd(rtab, u, wr, fr, rs); else { for (int a = 0; a < 2; ++a) for (int b = 0; b < 4; ++b) rs[a][b] = 1.0f; }
        const int col0 = u.pn * HALF + wc * 32 + 8 * fq;
#pragma unroll
        for (int ai = 0; ai < 2; ++ai)
#pragma unroll
            for (int m = 0; m < 4; ++m) {
                const int row = row0 + ai * HALF + m * 16;
                const float r = rs[ai][m];
                float h[8];
#pragma unroll
                for (int n = 0; n < 2; ++n)
#pragma unroll
                    for (int c = 0; c < 4; ++c) {
                        const float g = acc[ai][0][m][n][c] * r, uu = acc[ai][1][m][n][c] * r;
                        h[n * 4 + c] = g * __builtin_amdgcn_rcpf(1.0f + __builtin_amdgcn_exp2f(-1.4426950408889634f * g)) * uu;
                    }
                u32x4 w; w.x = cvt_pk_bf16(h[0], h[1]); w.y = cvt_pk_bf16(h[2], h[3]); w.z = cvt_pk_bf16(h[4], h[5]); w.w = cvt_pk_bf16(h[6], h[7]);
                *(u32x4*)((char*)O + ((unsigned)row * (unsigned)ldc + (unsigned)col0) * 2u) = w;
            }
    }
};
struct EpiResid {
    static constexpr bool PERM = true, AFTER_DRAIN = false;
    bf16_t* XB; float* part;
    __device__ __forceinline__ void operator()(const f32x4 (&acc)[2][2][4][2], const Unit& u, int wr, int wc, int fr, int fq) const {
        const int row0 = u.pm * BM + wr * 64 + fr, col0 = u.pn * BM + wc * 32 + 8 * fq;
#pragma unroll
        for (int ai = 0; ai < 2; ++ai)
#pragma unroll
            for (int m = 0; m < 4; ++m) {
                const int row = row0 + ai * HALF + m * 16;
                float ss = 0.f;
#pragma unroll
                for (int bj = 0; bj < 2; ++bj) {
                    u32x4* xp = (u32x4*)((char*)XB + ((unsigned)row * 1024u + (unsigned)(col0 + bj * HALF)) * 2u);
                    const u32x4 xo = *xp;
                    const f32x4 a0 = acc[ai][bj][m][0], a1 = acc[ai][bj][m][1];
                    float o[8];
                    o[0] = __uint_as_float(xo.x << 16) + a0[0]; o[1] = __uint_as_float(xo.x & 0xffff0000u) + a0[1]; o[2] = __uint_as_float(xo.y << 16) + a0[2]; o[3] = __uint_as_float(xo.y & 0xffff0000u) + a0[3];
                    o[4] = __uint_as_float(xo.z << 16) + a1[0]; o[5] = __uint_as_float(xo.z & 0xffff0000u) + a1[1]; o[6] = __uint_as_float(xo.w << 16) + a1[2]; o[7] = __uint_as_float(xo.w & 0xffff0000u) + a1[3];
                    u32x4 w; w.x = cvt_pk_bf16(o[0], o[1]); w.y = cvt_pk_bf16(o[2], o[3]); w.z = cvt_pk_bf16(o[4], o[5]); w.w = cvt_pk_bf16(o[6], o[7]);
                    *xp = w;
                    ss += ((o[0] * o[0] + o[1] * o[1]) + (o[2] * o[2] + o[3] * o[3])) + ((o[4] * o[4] + o[5] * o[5]) + (o[6] * o[6] + o[7] * o[7]));
                }
                ss += shx<16>(ss); ss = xhalf_sum(ss);
                if (fq == 0) *(float*)((char*)part + ((unsigned)row * 64u + (unsigned)(4 * u.pn + wc) * 4u)) = ss;
            }
    }
};
struct EpiNull {
    static constexpr bool PERM = false, AFTER_DRAIN = false;
    __device__ __forceinline__ void operator()(const f32x4 (&acc)[2][2][4][2], const Unit&, int, int, int, int) const {
#pragma unroll
        for (int ai = 0; ai < 2; ++ai)
#pragma unroll
            for (int bj = 0; bj < 2; ++bj)
#pragma unroll
                for (int m = 0; m < 4; ++m)
#pragma unroll
                    for (int n = 0; n < 2; ++n) asm volatile("" :: "v"(acc[ai][bj][m][n]));
    }
};
template <class Epi, class Sched, bool ALIGN_EPI = false, bool SP2 = false>
__device__ __forceinline__ void gemm_phase(PG8_LAS unsigned char* lds, const Gemm g, const Sched& S, const Epi& E, const int wave_in) {
    int tid_; asm volatile("v_mbcnt_lo_u32_b32 %0, -1, 0\n\tv_mbcnt_hi_u32_b32 %0, -1, %0" : "=v"(tid_)); tid_ += wave_in * 64; asm volatile("" : "+v"(tid_));
    const int tid = tid_, wid = __builtin_amdgcn_readfirstlane(tid >> 6), lane = tid & 63, wr = wid >> 2, wc = wid & 3, fr = lane & 15, fq = lane >> 4;
    const int K = g.K, nt = K / BK;
    unsigned voffA[2], voffB[2];
#pragma unroll
    for (int i = 0; i < 2; ++i) { int R, C; stage_rc(tid * 16 + i * 8192, R, C); const int Rb = Epi::PERM ? ((R & ~31) + perm32(R & 31)) : R;
        voffA[i] = (unsigned)(R * K + C) * 2u; voffB[i] = (unsigned)(Rb * K + C) * 2u; }
    const size_t kstep = (size_t)(BK * 2);
    const size_t hstep = (size_t)HALF * K * 2;
    const size_t tstep = 2 * hstep;
    const unsigned ldsw = (unsigned)wid * 1024u;
    const int aoff = lds_byte(wr * 64 + fr, fq * 8), boff = lds_byte(wc * 32 + fr, fq * 8);
#define PG8_SA(b, h) (((b) * 2 + (h)) * HTB)
#define PG8_SB(b, h) ((4 + (b) * 2 + (h)) * HTB)
#define PG8_STAGE(bufoff, gbase, voff) do { _Pragma("unroll") for (int _i = 0; _i < 2; ++_i) \
        __builtin_amdgcn_global_load_lds((const unsigned*)((const char*)(gbase) + (voff)[_i]), (PG8_LAS unsigned*)(lds + (bufoff) + ldsw + _i * 8192), 16, 0, 0); } while (0)
#define PG8_LDA(dst, b, h) do { _Pragma("unroll") for (int m = 0; m < 4; ++m) _Pragma("unroll") for (int k = 0; k < 2; ++k) dst[m][k] = *(const PG8_LAS bf16x8*)(lds + PG8_SA(b, h) + aoff + m * 2048 + k * 1024); } while (0)
#define PG8_LDB(dst, b, h) do { _Pragma("unroll") for (int n = 0; n < 2; ++n) _Pragma("unroll") for (int k = 0; k < 2; ++k) dst[n][k] = *(const PG8_LAS bf16x8*)(lds + PG8_SB(b, h) + boff + n * 2048 + k * 1024); } while (0)
#define PG8_MMA(ai, bj, At, Bt) do { __builtin_amdgcn_s_setprio(1); _Pragma("unroll") for (int m = 0; m < 4; ++m) _Pragma("unroll") for (int n = 0; n < 2; ++n) _Pragma("unroll") for (int k = 0; k < 2; ++k) \
        acc[ai][bj][m][n] = __builtin_amdgcn_mfma_f32_16x16x32_bf16(Bt[n][k], At[m][k], acc[ai][bj][m][n], 0, 0, 0); __builtin_amdgcn_s_setprio(0); } while (0)
#define PG8_WAIT_V(n) asm volatile("s_waitcnt vmcnt(" #n ")" ::: "memory")
#define PG8_WAIT_L(n) asm volatile("s_waitcnt lgkmcnt(" #n ")" ::: "memory")
#define PG8_BAR __builtin_amdgcn_s_barrier()
#define PG8_SCHED __builtin_amdgcn_sched_barrier(0)
    Unit cur, nxt; int ui = 0;
    if (!S.next(0, cur)) return;
    f32x4 acc[2][2][4][2];
#pragma unroll
    for (int a = 0; a < 2; ++a)
#pragma unroll
        for (int b = 0; b < 2; ++b)
#pragma unroll
            for (int m = 0; m < 4; ++m)
#pragma unroll
                for (int n = 0; n < 2; ++n) acc[a][b][m][n] = (f32x4){0.f, 0.f, 0.f, 0.f};
    bf16x8 At[4][2], B0[2][2], B1[2][2];
    const char* cA = (const char*)g.A + (size_t)cur.pm * tstep; const char* cB = (const char*)g.Bt + (size_t)cur.pn * tstep;
    S.a_ready(cur);
    if constexpr (SP2) {
        PG8_STAGE(PG8_SB(0, 0), cB, voffB); PG8_STAGE(PG8_SB(0, 1), cB + hstep, voffB); PG8_STAGE(PG8_SA(0, 0), cA, voffA); PG8_STAGE(PG8_SA(0, 1), cA + hstep, voffA);
        if (wr == 1) PG8_BAR;
        PG8_WAIT_V(2); PG8_BAR;
        PG8_STAGE(PG8_SB(1, 0), cB + kstep, voffB); PG8_STAGE(PG8_SA(1, 0), cA + kstep, voffA); PG8_STAGE(PG8_SB(1, 1), cB + hstep + kstep, voffB);
        PG8_WAIT_V(6); PG8_BAR;
    } else {
        PG8_STAGE(PG8_SB(0, 0), cB, voffB); PG8_STAGE(PG8_SA(0, 0), cA, voffA); PG8_STAGE(PG8_SB(0, 1), cB + hstep, voffB); PG8_STAGE(PG8_SA(0, 1), cA + hstep, voffA);
        if (wr == 1) PG8_BAR;
        PG8_WAIT_V(4); PG8_BAR;
        PG8_STAGE(PG8_SB(1, 0), cB + kstep, voffB); PG8_STAGE(PG8_SA(1, 0), cA + kstep, voffA); PG8_STAGE(PG8_SB(1, 1), cB + hstep + kstep, voffB);
        PG8_WAIT_V(6); PG8_BAR;
    }
    for (;;) {
        const bool has_next = S.next(ui + 1, nxt);
        const char* nA = has_next ? (const char*)g.A + (size_t)nxt.pm * tstep : cA; const char* nB = has_next ? (const char*)g.Bt + (size_t)nxt.pn * tstep : cB;
        for (int t = 0; t < nt; t += 2) {
            const bool last = (t == nt - 2);
            const char* a1 = cA + (size_t)(t + 1) * kstep;
            const char* a2 = last ? nA : cA + (size_t)(t + 2) * kstep; const char* b2 = last ? nB : cB + (size_t)(t + 2) * kstep;
            const char* a3 = a2 + kstep; const char* b3 = b2 + kstep;
            if (last && has_next) S.a_ready(nxt);
            if constexpr (SP2) {
            PG8_LDB(B0, 0, 0); PG8_LDB(B1, 0, 1); PG8_SCHED; PG8_LDA(At, 0, 0); PG8_STAGE(PG8_SA(1, 1), a1 + hstep, voffA);
            PG8_WAIT_V(8); PG8_WAIT_L(0); PG8_BAR; PG8_MMA(0, 0, At, B0); PG8_MMA(0, 1, At, B1); PG8_BAR; PG8_SCHED;
            PG8_LDA(At, 0, 1); PG8_STAGE(PG8_SB(0, 0), b2, voffB); PG8_STAGE(PG8_SB(0, 1), b2 + hstep, voffB); PG8_STAGE(PG8_SA(0, 0), a2, voffA);
            PG8_WAIT_V(8); PG8_WAIT_L(0); PG8_BAR; PG8_MMA(1, 0, At, B0); PG8_MMA(1, 1, At, B1); PG8_BAR; PG8_SCHED;
            PG8_LDB(B0, 1, 0); PG8_LDB(B1, 1, 1); PG8_SCHED; PG8_LDA(At, 1, 0); PG8_STAGE(PG8_SA(0, 1), a2 + hstep, voffA);
            PG8_WAIT_V(8); PG8_WAIT_L(0); PG8_BAR; PG8_MMA(0, 0, At, B0); PG8_MMA(0, 1, At, B1); PG8_BAR; PG8_SCHED;
            PG8_LDA(At, 1, 1); PG8_STAGE(PG8_SB(1, 0), b3, voffB); PG8_STAGE(PG8_SB(1, 1), b3 + hstep, voffB); PG8_STAGE(PG8_SA(1, 0), a3, voffA);
            PG8_WAIT_V(8); PG8_WAIT_L(0); PG8_BAR; PG8_MMA(1, 0, At, B0); PG8_MMA(1, 1, At, B1); PG8_BAR; PG8_SCHED;
            } else {
            PG8_LDB(B0, 0, 0); PG8_SCHED; PG8_LDA(At, 0, 0); PG8_STAGE(PG8_SA(1, 1), a1 + hstep, voffA);
            PG8_WAIT_L(8); PG8_BAR; PG8_WAIT_L(0); PG8_MMA(0, 0, At, B0); PG8_BAR; PG8_SCHED;
            PG8_LDB(B1, 0, 1); PG8_STAGE(PG8_SB(0, 0), b2, voffB);
            PG8_BAR; PG8_WAIT_L(0); PG8_MMA(0, 1, At, B1); PG8_BAR;
            PG8_LDA(At, 0, 1); PG8_STAGE(PG8_SA(0, 0), a2, voffA);
            PG8_BAR; PG8_WAIT_L(0); PG8_MMA(1, 0, At, B0); PG8_BAR; PG8_SCHED;
            PG8_STAGE(PG8_SB(0, 1), b2 + hstep, voffB);
            PG8_WAIT_V(6); PG8_BAR; PG8_MMA(1, 1, At, B1); PG8_BAR;
            PG8_LDB(B0, 1, 0); PG8_SCHED; PG8_LDA(At, 1, 0); PG8_STAGE(PG8_SA(0, 1), a2 + hstep, voffA);
            PG8_WAIT_L(8); PG8_BAR; PG8_WAIT_L(0); PG8_MMA(0, 0, At, B0); PG8_BAR; PG8_SCHED;
            PG8_LDB(B1, 1, 1); PG8_STAGE(PG8_SB(1, 0), b3, voffB);
            PG8_BAR; PG8_WAIT_L(0); PG8_MMA(0, 1, At, B1); PG8_BAR;
            PG8_LDA(At, 1, 1); PG8_STAGE(PG8_SA(1, 0), a3, voffA);
            PG8_BAR; PG8_WAIT_L(0); PG8_MMA(1, 0, At, B0); PG8_BAR; PG8_SCHED;
            PG8_STAGE(PG8_SB(1, 1), b3 + hstep, voffB);
            PG8_WAIT_V(6); PG8_BAR; PG8_MMA(1, 1, At, B1); PG8_BAR;
            }
        }
        if constexpr (ALIGN_EPI) { if (wr == 0) PG8_BAR; }
        if constexpr (!Epi::AFTER_DRAIN) { E(acc, cur, wr, wc, fr, fq); S.done(cur); }
        if (!has_next) break;
#pragma unroll
        for (int a = 0; a < 2; ++a)
#pragma unroll
            for (int b = 0; b < 2; ++b)
#pragma unroll
                for (int m = 0; m < 4; ++m)
#pragma unroll
                    for (int n = 0; n < 2; ++n) acc[a][b][m][n] = (f32x4){0.f, 0.f, 0.f, 0.f};
        cur = nxt; cA = nA; cB = nB; ++ui;
        if constexpr (ALIGN_EPI) { if (wr == 1) PG8_BAR; }
    }
    PG8_WAIT_V(0);
    if constexpr (!ALIGN_EPI) { if (wr == 0) PG8_BAR; }
    PG8_BAR;
    if constexpr (Epi::AFTER_DRAIN) { E.fused(acc, cur, wr, wc, fr, fq, lds, wid, lane); S.done(cur); }
#undef PG8_SA
#undef PG8_SB
#undef PG8_STAGE
#undef PG8_LDA
#undef PG8_LDB
#undef PG8_MMA
#undef PG8_WAIT_V
#undef PG8_WAIT_L
#undef PG8_BAR
#undef PG8_SCHED
}
}
#define GAS __attribute__((address_space(1)))
#define LAS __attribute__((address_space(3)))
typedef unsigned short bf16;
typedef unsigned v4u __attribute__((ext_vector_type(4)));
typedef float f32x4 __attribute__((ext_vector_type(4)));
typedef short bf16x8 __attribute__((ext_vector_type(8)));
typedef GAS unsigned gu32;
typedef GAS unsigned long long gu64;
#define RLX_AGENT __ATOMIC_RELAXED, __HIP_MEMORY_SCOPE_AGENT
#define LDS_WAIT() asm volatile("s_waitcnt lgkmcnt(0)" ::: "memory")
#define VM_WAIT() asm volatile("s_waitcnt vmcnt(0)" ::: "memory")
__device__ __forceinline__ unsigned long long rt() { return __builtin_amdgcn_s_memrealtime(); }
__device__ __forceinline__ unsigned f2bf(float f) { unsigned u = __builtin_bit_cast(unsigned, f); return (u + 0x7fffu + ((u >> 16) & 1u)) >> 16; }
__device__ __forceinline__ unsigned pk2(float lo, float hi) { return f2bf(lo) | (f2bf(hi) << 16); }

#define XB_TMO      128
#define XB_XCNT(j)  (256  + 64 * (j))
#define XB_XSUB(j)  (1280 + 64 * (j))
#define XB_XGEN(j)  (2304 + 64 * (j))
#define XB_TOP      3328
#define XB_TOPGEN   3392
#define XCD_BAR_WORDS 3456
#define XB_SPIN_CAP (1u << 18)

__device__ __forceinline__ unsigned xb_ld(unsigned* p)              { return __hip_atomic_load(p, __ATOMIC_RELAXED, __HIP_MEMORY_SCOPE_AGENT); }
__device__ __forceinline__ unsigned xb_add(unsigned* p, unsigned v) { return __hip_atomic_fetch_add(p, v, __ATOMIC_RELAXED, __HIP_MEMORY_SCOPE_AGENT); }
__device__ __forceinline__ unsigned xb_xcc_id() { return (unsigned)__builtin_amdgcn_s_getreg((3 << 11) | 20) & 0xFu; }
#define XB_SPIN(cond, bar) do { unsigned _sp = 0; while (cond) { __builtin_amdgcn_s_sleep(1); \
    if ((++_sp & 255u) == 0u) { if (xb_ld(&(bar)[XB_TMO])) break; if (_sp > XB_SPIN_CAP) { atomicAdd(&(bar)[XB_TMO], 1u); break; } } } } while (0)

struct XcdBarrier {
    unsigned* bar; unsigned x;
    volatile LAS unsigned* st;
};

__device__ __forceinline__ XcdBarrier xcd_barrier_post(unsigned* bar, volatile LAS unsigned* st) {
    XcdBarrier b; b.bar = bar; b.x = xb_xcc_id(); b.st = st;
    if (threadIdx.x == 0) (void)xb_add(&bar[XB_XCNT(b.x)], 1u);
    return b;
}
__device__ __forceinline__ void xcd_barrier_complete(unsigned* bar, unsigned x, unsigned& nloc, unsigned& nx) {
    const unsigned G = gridDim.x * gridDim.y * gridDim.z;
    unsigned sum, cnt, mine, sp = 0u;
    for (;;) {
        sum = 0u; cnt = 0u; mine = 0u;
#pragma unroll
        for (unsigned j = 0; j < 16; ++j) { const unsigned c = xb_ld(&bar[XB_XCNT(j)]); sum += c; cnt += (c > 0u) ? 1u : 0u; mine = (j == x) ? c : mine; }
        if (sum == G) break;
        __builtin_amdgcn_s_sleep(1);
        if ((++sp & 255u) == 0u) { if (xb_ld(&bar[XB_TMO])) break; if (sp > XB_SPIN_CAP) { atomicAdd(&bar[XB_TMO], 1u); break; } }
    }
    nloc = mine > 0u ? mine : 1u; nx = cnt > 0u ? cnt : 1u;
}

__device__ __forceinline__ void xcd_barrier(const XcdBarrier& b) {
    asm volatile("s_waitcnt vmcnt(0)" ::: "memory");
    __syncthreads();
    if (threadIdx.x == 0) {
        unsigned* bar = b.bar;
        __builtin_amdgcn_s_waitcnt(0);
        unsigned nloc = b.st[0], nx = b.st[1];
        if (nloc == 0u) { xcd_barrier_complete(bar, b.x, nloc, nx); b.st[0] = nloc; b.st[1] = nx; }
        const unsigned old = xb_add(&bar[XB_XSUB(b.x)], 1u);
        const unsigned gen = old / nloc;
        if (old + 1u == (gen + 1u) * nloc) {
            __builtin_amdgcn_fence(__ATOMIC_RELEASE, "agent");
            asm volatile("s_waitcnt vmcnt(0)" ::: "memory");
            const unsigned og = xb_add(&bar[XB_TOP], 1u);
            const unsigned tg = og / nx;
            if (og + 1u == (tg + 1u) * nx) xb_add(&bar[XB_TOPGEN], 1u);
            else XB_SPIN(xb_ld(&bar[XB_TOPGEN]) == tg, bar);
            __builtin_amdgcn_fence(__ATOMIC_ACQUIRE, "agent");
            xb_add(&bar[XB_XGEN(b.x)], 1u);
            asm volatile("s_waitcnt vmcnt(0)" ::: "memory");
        } else {
            XB_SPIN(xb_ld(&bar[XB_XGEN(b.x)]) == gen, bar);
            __builtin_amdgcn_fence(__ATOMIC_ACQUIRE, "agent");
            asm volatile("s_waitcnt vmcnt(0)" ::: "memory");
        }
    }
    __syncthreads();
}


constexpr int NWAVES = 8;
constexpr int M = 16384, SEQ = 8192, D = 1024, DFF = 2816, MW = 3088, MP = 3072, AW = 1536;
constexpr float EPS = 1e-6f;
constexpr size_t MiB = 1u << 20;
constexpr size_t WS_CTL = 0, CTL_ZERO_BYTES = 1 * MiB;
constexpr size_t WS_PART = 1 * MiB;
constexpr size_t WS_GATES = 2 * MiB;
constexpr size_t WS_SMALL = 3 * MiB;
constexpr size_t WS_ROPE = 4 * MiB;
constexpr size_t WS_NBUF = 8 * MiB;
constexpr size_t WS_WG = 9 * MiB;
constexpr size_t WS_W = 10 * MiB;
constexpr size_t W_MIN = WS_W, W_MOUT = W_MIN + 12 * MiB, W_AIN = W_MOUT + 4 * MiB, W_AOUT = W_AIN + 6 * MiB, W_FIN = W_AOUT + 4 * MiB, W_FOUT = W_FIN + 44 * MiB;
constexpr size_t WS_XB = 102 * MiB;
constexpr size_t WS_HS = 134 * MiB;
constexpr size_t WS_PROJ = 166 * MiB;
constexpr size_t WS_KV = 262 * MiB;
constexpr size_t WS_END = 326 * MiB;
static_assert(W_FOUT + 22 * MiB == WS_XB, "weight map");
constexpr int CW_BAR = 4096;

constexpr int RING_OFF = 0, RING_BYTES = 131072;
constexpr int LDSCTL_OFF = RING_BYTES, MISC_OFF = LDSCTL_OFF + 320;
constexpr int LDS_BYTES = 147456;

using pg8::shx; using pg8::xhalf_sum; using pg8::xhalf_max;
__device__ __forceinline__ float wave_sum(float v) { v += shx<1>(v); v += shx<2>(v); v += shx<4>(v); v += shx<8>(v); v += shx<16>(v); return xhalf_sum(v); }
__device__ __forceinline__ float wave_max(float v) { v = fmaxf(v, shx<1>(v)); v = fmaxf(v, shx<2>(v)); v = fmaxf(v, shx<4>(v)); v = fmaxf(v, shx<8>(v)); v = fmaxf(v, shx<16>(v)); return xhalf_max(v); }
#define DPPF(old, src, ctrl, rm) __int_as_float(__builtin_amdgcn_update_dpp(__float_as_int(old), __float_as_int(src), ctrl, rm, 0xf, false))
__device__ __forceinline__ float wscan_add(float v) {
    v += DPPF(0.f, v, 0x111, 0xf); v += DPPF(0.f, v, 0x112, 0xf); v += DPPF(0.f, v, 0x114, 0xf); v += DPPF(0.f, v, 0x118, 0xf); v += DPPF(0.f, v, 0x142, 0xa); v += DPPF(0.f, v, 0x143, 0xc); return v; }
__device__ __forceinline__ float wscan_max(float v) {
    const float ni = -INFINITY;
    v = fmaxf(v, DPPF(ni, v, 0x111, 0xf)); v = fmaxf(v, DPPF(ni, v, 0x112, 0xf)); v = fmaxf(v, DPPF(ni, v, 0x114, 0xf)); v = fmaxf(v, DPPF(ni, v, 0x118, 0xf)); v = fmaxf(v, DPPF(ni, v, 0x142, 0xa)); v = fmaxf(v, DPPF(ni, v, 0x143, 0xc)); return v; }
__device__ __forceinline__ float wave_shr1(float v, float fill) { return DPPF(fill, v, 0x138, 0xf); }
__device__ __forceinline__ float lane63(float v) { return __int_as_float(__builtin_amdgcn_readlane(__float_as_int(v), 63)); }
__device__ __forceinline__ float bf2f(unsigned short b) { return __uint_as_float((unsigned)b << 16); }
__device__ __forceinline__ float log_sigmoidf(float x) { return fminf(x, 0.f) - __logf(1.0f + __expf(-fabsf(x))); }

struct Args { const float* in[14]; float* out; unsigned char* ws; int ph_lo, ph_hi, dup, pad; };

struct ColMap {
    int type;
    __device__ __forceinline__ int dst(int s) const {
        if (type == 2) { if (s >= 1280) return s; const int p = s & 63; return (s & ~63) + (p < 32 ? 2 * p : 2 * (p - 32) + 1); }
        if (type == 3) { return s < DFF ? 256 * (s >> 7) + (s & 127) : 256 * ((s - DFF) >> 7) + 128 + ((s - DFF) & 127); }
        return s;
    }
    __device__ __forceinline__ float scale(int s) const {
        if (type == 1) return s < 512 ? 0.08838834764831845f : 1.0f;
#ifdef ATTN_OLD
        if (type == 2) return s < 1024 ? 0.125f : 1.0f;
#else
        if (type == 2) return s < 1024 ? 0.18033688011112042f : 1.0f;
#endif
        return 1.0f;
    }
};
__device__ __forceinline__ void wt_item(const float* W, int ldn, int K, const float* nw, bf16* WT, ColMap mp, LAS float* scr, int item, int nblk, int lane) {
    const int kb = item / nblk, nb = item % nblk, k0 = 64 * kb, s0 = 32 * nb;
    const int ks = lane >> 3, c4 = lane & 7;
    f32x4 v[8];
#pragma unroll
    for (int i = 0; i < 8; ++i) v[i] = *(const GAS f32x4*)(W + (size_t)(k0 + 8 * i + ks) * ldn + s0 + 4 * c4);
    const float sc = mp.scale(s0 + 4 * c4);
#pragma unroll
    for (int i = 0; i < 8; ++i) { const float w = nw ? nw[k0 + 8 * i + ks] * sc : sc; LAS float* d = scr + (8 * i + ks) * 33 + 4 * c4;
        d[0] = v[i].x * w; d[1] = v[i].y * w; d[2] = v[i].z * w; d[3] = v[i].w * w; }
    LDS_WAIT(); asm volatile("" ::: "memory");
    const int c = lane & 7;
#pragma unroll
    for (int j = 0; j < 4; ++j) { const int n = (lane >> 3) + 8 * j; const LAS float* sp = scr + (8 * c) * 33 + n;
        v4u o; o.x = pk2(sp[0 * 33], sp[1 * 33]); o.y = pk2(sp[2 * 33], sp[3 * 33]); o.z = pk2(sp[4 * 33], sp[5 * 33]); o.w = pk2(sp[6 * 33], sp[7 * 33]);
        *(GAS v4u*)(WT + (size_t)mp.dst(s0 + n) * K + k0 + 8 * c) = o; }
    LDS_WAIT(); asm volatile("" ::: "memory");
}

struct Ptrs {
    const float *x; const int* pos; const float *norm_mix_w, *norm_ffn_w, *norm_final_w, *mlstm_w_in, *mlstm_b_gate, *mlstm_norm_w, *mlstm_w_out, *attn_w_in, *attn_sink, *attn_w_out, *ffn_w_in, *ffn_w_out;
    float* out; unsigned char* ws;
};

__device__ __forceinline__ void p0_prologue(const Ptrs& P, LAS unsigned char* lds, int vcu, int G, int wave, int lane) {
    LAS float* scr = (LAS float*)(lds + RING_OFF + wave * 16384);
    const int gw = vcu * NWAVES + wave, NGW = G * NWAVES;
    constexpr int I_MIN = 16 * 96, I_SQ = 16 * 32, I_AIN = 16 * 48, I_FIN = 16 * 176, I_FOUT = 44 * 32;
    constexpr int NITEMS = 2 * I_MIN + 2 * I_SQ + 2 * I_AIN + 2 * I_SQ + 4 * I_FIN + 4 * I_FOUT;
    unsigned char* ws = P.ws;
    for (int it = gw; it < NITEMS; it += NGW) {
        int r = it;
        if (r < 2 * I_MIN) { const int L = r / I_MIN; r %= I_MIN; wt_item(P.mlstm_w_in + (size_t)L * D * MW, MW, D, P.norm_mix_w + (2 * L) * D, (bf16*)(ws + W_MIN) + (size_t)L * MP * D, ColMap{1}, scr, r, MP / 32, lane); continue; } r -= 2 * I_MIN;
        if (r < 2 * I_SQ) { const int L = r / I_SQ; r %= I_SQ; wt_item(P.mlstm_w_out + (size_t)L * D * D, D, D, nullptr, (bf16*)(ws + W_MOUT) + (size_t)L * D * D, ColMap{0}, scr, r, D / 32, lane); continue; } r -= 2 * I_SQ;
        if (r < 2 * I_AIN) { const int L = r / I_AIN; r %= I_AIN; wt_item(P.attn_w_in + (size_t)L * D * AW, AW, D, P.norm_mix_w + (2 * L + 1) * D, (bf16*)(ws + W_AIN) + (size_t)L * AW * D, ColMap{2}, scr, r, AW / 32, lane); continue; } r -= 2 * I_AIN;
        if (r < 2 * I_SQ) { const int L = r / I_SQ; r %= I_SQ; wt_item(P.attn_w_out + (size_t)L * D * D, D, D, nullptr, (bf16*)(ws + W_AOUT) + (size_t)L * D * D, ColMap{0}, scr, r, D / 32, lane); continue; } r -= 2 * I_SQ;
        if (r < 4 * I_FIN) { const int L = r / I_FIN; r %= I_FIN; wt_item(P.ffn_w_in + (size_t)L * D * 2 * DFF, 2 * DFF, D, P.norm_ffn_w + L * D, (bf16*)(ws + W_FIN) + (size_t)L * 2 * DFF * D, ColMap{3}, scr, r, 2 * DFF / 32, lane); continue; } r -= 4 * I_FIN;
        { const int L = r / I_FOUT; r %= I_FOUT; wt_item(P.ffn_w_out + (size_t)L * DFF * D, D, DFF, nullptr, (bf16*)(ws + W_FOUT) + (size_t)L * D * DFF, ColMap{0}, scr, r, D / 32, lane); }
    }
    float* part = (float*)(ws + WS_PART); bf16* xb = (bf16*)(ws + WS_XB);
    for (int m = gw; m < M; m += NGW) {
        const GAS f32x4* xr = (const GAS f32x4*)(P.x + (size_t)m * D) + lane;
        GAS unsigned long long* o8 = (GAS unsigned long long*)(xb + (size_t)m * D) + lane;
        float s = 0.f;
#pragma unroll
        for (int j = 0; j < 4; ++j) { const f32x4 v = xr[64 * j]; s += (v.x * v.x + v.y * v.y) + (v.z * v.z + v.w * v.w);
            o8[64 * j] = (unsigned long long)pk2(v.x, v.y) | ((unsigned long long)pk2(v.z, v.w) << 32); }
        s = wave_sum(s);
        if (lane < 16) part[(size_t)m * 16 + lane] = lane == 0 ? s : 0.f;
    }
    float* cosT = (float*)(ws + WS_ROPE); float* sinT = cosT + (size_t)M * 32;
    for (int idx = gw * 64 + lane; idx < M * 32; idx += NGW * 64) {
        const int t = idx >> 5, i = idx & 31;
        const float inv = powf(10000.0f, -(float)i / 32.0f);
        const float ang = (float)P.pos[t] * inv;
        cosT[idx] = cosf(ang); sinT[idx] = sinf(ang);
    }
    bf16* wg = (bf16*)(ws + WS_WG);
    for (int idx = gw * 64 + lane; idx < 2 * 16 * 1024; idx += NGW * 64) {
        const int L = idx >> 14, g = (idx >> 10) & 15, k = idx & 1023;
        wg[idx] = (bf16)f2bf(P.mlstm_w_in[(size_t)L * D * MW + (size_t)k * MW + 3072 + g] * P.norm_mix_w[(2 * L) * D + k]);
    }
}

typedef float f32x4v __attribute__((ext_vector_type(4)));
__device__ __forceinline__ void gates_step(const Ptrs& P, int L, LAS unsigned char* lds, int blk, int wave, int lane) {
    unsigned char* ws = P.ws;
    const bf16* xb = (const bf16*)(ws + WS_XB); const bf16* wg = (const bf16*)(ws + WS_WG) + (size_t)L * 16 * 1024;
    const float* part = (const float*)(ws + WS_PART); float* gates = (float*)(ws + WS_GATES);
    const int tg = wave & 3, kh = wave >> 2, fr = lane & 15, fq = lane >> 4;
    const int row0 = blk * 64 + tg * 16;
    f32x4v acc = {0.f, 0.f, 0.f, 0.f};
    const bf16* ap = xb + (size_t)(row0 + fr) * D + kh * 512 + fq * 8;
    const bf16* bp = wg + (size_t)fr * 1024 + kh * 512 + fq * 8;
#pragma unroll 4
    for (int s = 0; s < 16; ++s) {
        const bf16x8 a = *(const bf16x8*)(ap + s * 32), b = *(const bf16x8*)(bp + s * 32);
        acc = __builtin_amdgcn_mfma_f32_16x16x32_bf16(a, b, acc, 0, 0, 0);
    }
    LAS f32x4v* ex = (LAS f32x4v*)(lds + RING_OFF);
    if (kh == 1) ex[tg * 64 + lane] = acc;
    __syncthreads();
    if (kh == 0) {
        const f32x4v o = ex[tg * 64 + lane]; acc = acc + o;
        const int g = fr; const float bias = P.mlstm_b_gate[L * 16 + g];
#pragma unroll
        for (int r = 0; r < 4; ++r) {
            const int row = row0 + 4 * fq + r;
            float s = 0.f;
#pragma unroll
            for (int p = 0; p < 4; ++p) { const f32x4 pv = *(const f32x4*)(part + (size_t)row * 16 + 4 * p); s += (pv.x + pv.y) + (pv.z + pv.w); }
            const float rstd = rsqrtf(s * (1.0f / 1024.0f) + EPS);
            float v = acc[r] * rstd + bias;
            if (g & 4) v = log_sigmoidf(v);
            gates[(size_t)row * 16 + g] = v;
        }
    }
    __syncthreads();
}

typedef float f32x16 __attribute__((ext_vector_type(16)));
typedef short s16x4 __attribute__((ext_vector_type(4)));
typedef unsigned v2u __attribute__((ext_vector_type(2)));
constexpr int XTRA_OFF = LDSCTL_OFF + 1024;
static_assert(XTRA_OFF + 15 * 1024 <= LDS_BYTES, "LDS map");

__device__ __forceinline__ int crow(int r, int hh) { return (r & 3) + 8 * (r >> 2) + 4 * hh; }
__device__ __forceinline__ s16x4 tr_read(LAS const unsigned char* p) { return __builtin_bit_cast(s16x4, __builtin_amdgcn_ds_read_tr16_b64_v4i16((LAS s16x4*)p)); }
__device__ __forceinline__ bf16x8 cat8(s16x4 lo, s16x4 hi) { return (bf16x8){lo[0], lo[1], lo[2], lo[3], hi[0], hi[1], hi[2], hi[3]}; }
typedef float cv_f32x2 __attribute__((ext_vector_type(2))); typedef __bf16 cv_bf16x2 __attribute__((ext_vector_type(2)));
__device__ __forceinline__ unsigned cvtpk(float lo, float hi) { const cv_f32x2 v = {lo, hi}; const cv_bf16x2 b = __builtin_convertvector(v, cv_bf16x2); return __builtin_bit_cast(unsigned, b); }

#ifdef ATTN_OLD
constexpr int AT_ROWS = 320, AT_K = 0, AT_V = AT_ROWS * 128, AT_WS = 2 * AT_ROWS * 128, AT_OST = AT_WS + 2048;
static_assert(AT_OST + 8 * 4096 <= RING_BYTES, "attention LDS map");
__device__ __forceinline__ void attn_phase(const bf16* proj, const float* sink, bf16* hs, LAS unsigned char* lds, int vcu, int G, int tid, const int dry = 0) {
    const int wave = __builtin_amdgcn_readfirstlane(tid >> 6), g = wave & 3, rb = wave >> 2;
    LAS float* wsf = (LAS float*)(lds + AT_WS) + wave * 64;
    LAS unsigned char* ost = lds + AT_OST + wave * 4096;
    v4u kreg[5], vreg[5]; bf16x8 qreg[4];
#define AT_LOAD(item_) do { const int b_ = (item_) >> 9, hkv_ = ((item_) >> 7) & 3, q0_ = ((item_) & 127) * 64; \
        _Pragma("unroll") for (int i = 0; i < 5; ++i) { const int idx = tid_i + 512 * i, row = idx >> 3, c = idx & 7, kp = q0_ - 128 + row; \
            kreg[i] = (v4u){0u, 0u, 0u, 0u}; vreg[i] = (v4u){0u, 0u, 0u, 0u}; \
            if (kp >= 0 && kp < SEQ) { const bf16* src = proj + (size_t)(b_ * SEQ + kp) * AW + 1024 + hkv_ * 64 + c * 8; kreg[i] = *(const v4u*)src; vreg[i] = *(const v4u*)(src + 256); } } \
        { const bf16* qp = proj + (size_t)(b_ * SEQ + q0_ + 32 * rb + (tid_i & 31)) * AW + (hkv_ * 4 + g) * 64 + 8 * ((tid_i >> 5) & 1); \
          _Pragma("unroll") for (int s = 0; s < 4; ++s) qreg[s] = *(const bf16x8*)(qp + 16 * s); } } while (0)
    { int tid_i = tid; if (vcu < 1024) AT_LOAD(vcu); }
    for (int item = vcu; item < 1024; item += G) {
        int tid_i = tid; asm volatile("" : "+v"(tid_i));
        const int lane = tid_i & 63, r32 = lane & 31, hh = lane >> 5;
        const int b = item >> 9, hkv = (item >> 7) & 3, qb = item & 127, q0 = qb * 64, hq = hkv * 4 + g;
#pragma unroll
        for (int i = 0; i < 5; ++i) {
            const int idx = tid_i + 512 * i, row = idx >> 3, c = idx & 7;
            *(LAS v4u*)(lds + AT_K + row * 128 + ((c ^ ((row >> 1) & 7)) << 4)) = kreg[i];
            *(LAS v4u*)(lds + AT_V + row * 128 + ((c ^ (((row >> 1) & 1) << 2)) << 4)) = vreg[i];
        }
        bf16x8 qf[4];
#pragma unroll
        for (int s = 0; s < 4; ++s) qf[s] = qreg[s];
        __syncthreads();
        if (item + G < 1024) AT_LOAD(item + G);
        float m = sink[hq], l = hh == 0 ? 1.0f : 0.0f;
        f32x16 o[2]; o[0] = (f32x16){}; o[1] = (f32x16){};
        const int qpos = q0 + 32 * rb + r32;
        for (int kb = 0; kb < 9; ++kb) {
            const int krow0 = 32 * rb + 32 * kb;
            f32x16 x = (f32x16){};
            { const int kr = krow0 + r32; LAS const unsigned char* kbp = lds + AT_K + kr * 128; const int sw = (kr >> 1) & 7;
#pragma unroll
              for (int s = 0; s < 4; ++s) { const bf16x8 kf = *(LAS const bf16x8*)(kbp + (((2 * s + hh) ^ sw) << 4)); x = __builtin_amdgcn_mfma_f32_32x32x16_bf16(kf, qf[s], x, 0, 0, 0); } }
            float bmax = -INFINITY;
#pragma unroll
            for (int r = 0; r < 16; ++r) { const int kp = q0 - 128 + krow0 + crow(r, hh); const int dd = qpos - kp;
                const bool ok = (kp >= 0) && (kp < SEQ) && (dd <= 128) && (dd >= -128);
                x[r] = ok ? x[r] : -INFINITY; bmax = fmaxf(bmax, x[r]); }
            bmax = xhalf_max(bmax);
            const float mn = fmaxf(m, bmax), f = __expf(m - mn);
            m = mn;
            float ps = 0.f;
#pragma unroll
            for (int r = 0; r < 16; ++r) { x[r] = __expf(x[r] - mn); ps += x[r]; }
            l = l * f + ps;
            if (hh == 0) wsf[r32] = f;
            bf16x8 pa[2];
#pragma unroll
            for (int s = 0; s < 2; ++s) { v4u w; w.x = cvtpk(x[8 * s + 0], x[8 * s + 1]); w.y = cvtpk(x[8 * s + 2], x[8 * s + 3]); w.z = cvtpk(x[8 * s + 4], x[8 * s + 5]); w.w = cvtpk(x[8 * s + 6], x[8 * s + 7]); pa[s] = __builtin_bit_cast(bf16x8, w); }
            LDS_WAIT();
#pragma unroll
            for (int r = 0; r < 16; ++r) { const float fr_ = wsf[crow(r, hh)]; o[0][r] *= fr_; o[1][r] *= fr_; }
#pragma unroll
            for (int s = 0; s < 2; ++s)
#pragma unroll
                for (int eb = 0; eb < 2; ++eb) {
                    const int R0 = krow0 + 16 * s + 4 * hh + ((lane & 15) >> 2);
                    const int ch = 4 * eb + 2 * ((lane >> 4) & 1) + ((lane & 3) >> 1);
                    const s16x4 lo = tr_read(lds + AT_V + R0 * 128 + ((ch ^ (((R0 >> 1) & 1) << 2)) << 4) + 8 * (lane & 1));
                    const int R1 = R0 + 8;
                    const s16x4 hi = tr_read(lds + AT_V + R1 * 128 + ((ch ^ (((R1 >> 1) & 1) << 2)) << 4) + 8 * (lane & 1));
                    o[eb] = __builtin_amdgcn_mfma_f32_32x32x16_bf16(pa[s], cat8(lo, hi), o[eb], 0, 0, 0);
                }
        }
        l = xhalf_sum(l);
        if (hh == 0) wsf[32 + r32] = l;
        LDS_WAIT();
#pragma unroll
        for (int r = 0; r < 16; ++r) { const int t = crow(r, hh); const float rl = 1.0f / wsf[32 + t];
            *(LAS unsigned short*)(ost + t * 128 + r32 * 2) = (unsigned short)f2bf(o[0][r] * rl); *(LAS unsigned short*)(ost + t * 128 + 64 + r32 * 2) = (unsigned short)f2bf(o[1][r] * rl); }
        LDS_WAIT();
        { bf16* op = hs + (size_t)(b * SEQ + q0 + 32 * rb) * D + hq * 64;
#pragma unroll
          for (int i = 0; i < 4; ++i) { const int row = i * 8 + (lane >> 3), chn = lane & 7; const v4u v = *(LAS const v4u*)(ost + row * 128 + chn * 16); *(v4u*)(op + (size_t)row * D + chn * 8) = v; } }
        __syncthreads();
    }
#undef AT_LOAD
}

#else
constexpr int AT_ROWS = 320, AT_K = 0, AT_V = AT_ROWS * 128, AT_WS = 2 * AT_ROWS * 128, AT_OST = AT_WS + 2048;
static_assert(AT_OST + 8 * 4096 <= RING_BYTES, "attention LDS map");
__device__ __forceinline__ void attn_phase(const bf16* proj, const float* sink, bf16* hs, LAS unsigned char* lds, int vcu, int G, int tid, const int dry = 0) {
    const int wave = __builtin_amdgcn_readfirstlane(tid >> 6), g = wave & 3, rb = wave >> 2;
    LAS float* wsf = (LAS float*)(lds + AT_WS) + wave * 64;
    LAS unsigned char* ost = lds + AT_OST + wave * 4096;
    v4u kreg[5], vreg[5]; bf16x8 qreg[4];
#define AT_LOAD(item_) do { const int b_ = (item_) >> 9, hkv_ = ((item_) >> 7) & 3, q0_ = ((item_) & 127) * 64; \
        _Pragma("unroll") for (int i = 0; i < 5; ++i) { const int idx = tid_i + 512 * i, row = idx >> 3, c = idx & 7, kp = q0_ - 128 + row; \
            kreg[i] = (v4u){0u, 0u, 0u, 0u}; vreg[i] = (v4u){0u, 0u, 0u, 0u}; \
            if (kp >= 0 && kp < SEQ) { const bf16* src = proj + (size_t)(b_ * SEQ + kp) * AW + 1024 + hkv_ * 64 + c * 8; kreg[i] = *(const v4u*)src; vreg[i] = *(const v4u*)(src + 256); } } \
        { const bf16* qp = proj + (size_t)(b_ * SEQ + q0_ + 32 * rb + (tid_i & 31)) * AW + (hkv_ * 4 + g) * 64 + 8 * ((tid_i >> 5) & 1); \
          _Pragma("unroll") for (int s = 0; s < 4; ++s) qreg[s] = *(const bf16x8*)(qp + 16 * s); } } while (0)
    { int tid_i = tid; if (vcu < 1024) AT_LOAD(vcu); }
    for (int item = vcu; item < 1024; item += G) {
        int tid_i = tid; asm volatile("" : "+v"(tid_i));
        const int lane = tid_i & 63, r32 = lane & 31, hh = lane >> 5;
        const int b = item >> 9, hkv = (item >> 7) & 3, qb = item & 127, q0 = qb * 64, hq = hkv * 4 + g;
#pragma unroll
        for (int i = 0; i < 5; ++i) {
            const int idx = tid_i + 512 * i, row = idx >> 3, c = idx & 7;
            *(LAS v4u*)(lds + AT_K + row * 128 + ((c ^ ((row >> 1) & 7)) << 4)) = kreg[i];
            *(LAS v4u*)(lds + AT_V + row * 128 + ((c ^ (((row >> 1) & 1) << 2)) << 4)) = vreg[i];
        }
        bf16x8 qf[4];
#pragma unroll
        for (int s = 0; s < 4; ++s) qf[s] = qreg[s];
        __syncthreads();
        if (item + G < 1024) AT_LOAD(item + G);
        if (dry == 1) { asm volatile("" :: "v"(qf[0]), "v"(qf[1]), "v"(qf[2]), "v"(qf[3])); __syncthreads(); continue; }
        float m = sink[hq] * 1.4426950408889634f, l = hh == 0 ? 1.0f : 0.0f;
        f32x16 o[2]; o[0] = (f32x16){}; o[1] = (f32x16){};
        const int qpos = q0 + 32 * rb + r32;
        const bool edge_item = (q0 < 128) || (q0 + 192 > SEQ);
        for (int kb = 0; kb < (dry == 3 ? 1 : 9); ++kb) {
            const int krow0 = 32 * rb + 32 * kb;
            f32x16 x = (f32x16){};
            { const int kr = krow0 + r32; LAS const unsigned char* kbp = lds + AT_K + kr * 128; const int sw = (kr >> 1) & 7;
#pragma unroll
              for (int s = 0; s < 4; ++s) { const bf16x8 kf = *(LAS const bf16x8*)(kbp + (((2 * s + hh) ^ sw) << 4)); x = __builtin_amdgcn_mfma_f32_32x32x16_bf16(kf, qf[s], x, 0, 0, 0); } }
#ifdef AT_MASK_ALWAYS
            if (true) {
#else
            if (kb == 0 || kb == 8 || edge_item) {
#endif
#pragma unroll
                for (int r = 0; r < 16; ++r) { const int kp = q0 - 128 + krow0 + crow(r, hh); const int dd = qpos - kp;
                    const bool ok = (kp >= 0) && (kp < SEQ) && (dd <= 128) && (dd >= -128);
                    x[r] = ok ? x[r] : -INFINITY; }
            }
            float bmax = fmaxf(fmaxf(fmaxf(x[0], x[1]), fmaxf(x[2], x[3])), fmaxf(fmaxf(x[4], x[5]), fmaxf(x[6], x[7])));
            bmax = fmaxf(bmax, fmaxf(fmaxf(fmaxf(x[8], x[9]), fmaxf(x[10], x[11])), fmaxf(fmaxf(x[12], x[13]), fmaxf(x[14], x[15]))));
            bmax = xhalf_max(bmax);
#ifdef AT_RESCALE_ALWAYS
            if (true) {
#else
            if (__builtin_amdgcn_ballot_w64(bmax - m > 6.0f) != 0ull) {
#endif
                const float mn = fmaxf(m, bmax), f = __builtin_amdgcn_exp2f(m - mn);
                m = mn; l *= f;
                if (hh == 0) wsf[r32] = f;
                LDS_WAIT();
#pragma unroll
                for (int r = 0; r < 16; ++r) { const float fr_ = wsf[crow(r, hh)]; o[0][r] *= fr_; o[1][r] *= fr_; }
            }
            float ps = 0.f;
#pragma unroll
            for (int r = 0; r < 16; ++r) { x[r] = __builtin_amdgcn_exp2f(x[r] - m); ps += x[r]; }
            l += ps;
            bf16x8 pa[2];
#pragma unroll
            for (int s = 0; s < 2; ++s) { v4u w; w.x = cvtpk(x[8 * s + 0], x[8 * s + 1]); w.y = cvtpk(x[8 * s + 2], x[8 * s + 3]); w.z = cvtpk(x[8 * s + 4], x[8 * s + 5]); w.w = cvtpk(x[8 * s + 6], x[8 * s + 7]); pa[s] = __builtin_bit_cast(bf16x8, w); }
#pragma unroll
            for (int s = 0; s < 2; ++s)
#pragma unroll
                for (int eb = 0; eb < 2; ++eb) {
                    const int R0 = krow0 + 16 * s + 4 * hh + ((lane & 15) >> 2);
                    const int ch = 4 * eb + 2 * ((lane >> 4) & 1) + ((lane & 3) >> 1);
                    const s16x4 lo = tr_read(lds + AT_V + R0 * 128 + ((ch ^ (((R0 >> 1) & 1) << 2)) << 4) + 8 * (lane & 1));
                    const int R1 = R0 + 8;
                    const s16x4 hi = tr_read(lds + AT_V + R1 * 128 + ((ch ^ (((R1 >> 1) & 1) << 2)) << 4) + 8 * (lane & 1));
                    o[eb] = __builtin_amdgcn_mfma_f32_32x32x16_bf16(pa[s], cat8(lo, hi), o[eb], 0, 0, 0);
                }
        }
        if (dry >= 2) { asm volatile("" :: "v"(o[0]), "v"(o[1]), "v"(l)); __syncthreads(); continue; }
        l = xhalf_sum(l);
        if (hh == 0) wsf[32 + r32] = l;
        LDS_WAIT();
#pragma unroll
        for (int r = 0; r < 16; ++r) { const int t = crow(r, hh); const float rl = 1.0f / wsf[32 + t];
            *(LAS unsigned short*)(ost + t * 128 + r32 * 2) = (unsigned short)f2bf(o[0][r] * rl); *(LAS unsigned short*)(ost + t * 128 + 64 + r32 * 2) = (unsigned short)f2bf(o[1][r] * rl); }
        LDS_WAIT();
        { bf16* op = hs + (size_t)(b * SEQ + q0 + 32 * rb) * D + hq * 64;
#pragma unroll
          for (int i = 0; i < 4; ++i) { const int row = i * 8 + (lane >> 3), chn = lane & 7; const v4u v = *(LAS const v4u*)(ost + row * 128 + chn * 16); *(v4u*)(op + (size_t)row * D + chn * 8) = v; } }
        __syncthreads();
    }
#undef AT_LOAD
}

#endif
__device__ __forceinline__ int qk8(int row, int g8) { return row * 256 + ((g8 ^ (row & 31)) << 3); }
__device__ __forceinline__ int vt16(int row, int c16, int rowbytes) { return row * rowbytes + ((c16 ^ ((row & 3) << 2)) << 4); }
__device__ __forceinline__ void unpack8(v4u w, float (&f)[8]) {
    f[0] = __uint_as_float(w.x << 16); f[1] = __uint_as_float(w.x & 0xffff0000u); f[2] = __uint_as_float(w.y << 16); f[3] = __uint_as_float(w.y & 0xffff0000u);
    f[4] = __uint_as_float(w.z << 16); f[5] = __uint_as_float(w.z & 0xffff0000u); f[6] = __uint_as_float(w.w << 16); f[7] = __uint_as_float(w.w & 0xffff0000u);
}
constexpr int ML_A = 0, ML_B = 32768, ML_V = 65536;

__device__ __forceinline__ void mlstm_chunk_phase(const bf16* proj, const float* gates, bf16* kvb, float* nbuf, float* blam, LAS unsigned char* lds, int vcu, int G, int tid) {
    const int wave = __builtin_amdgcn_readfirstlane(tid >> 6), db = wave & 3, eh = wave >> 2;
    LAS float* gs = (LAS float*)(lds + XTRA_OFF);
    LAS float* wv = gs + 512;
    for (int item = vcu; item < 512; item += G) {
        int tid_i = tid; asm volatile("" : "+v"(tid_i));
        const int tid = tid_i, lane = tid & 63, hh = lane >> 5;
        const int bh = item >> 6, c = item & 63, b = bh >> 2, h = bh & 3, tok0 = b * SEQ + c * 128;
        { const int s = tid & 127, which = tid >> 7; gs[which * 128 + s] = gates[(size_t)(tok0 + s) * 16 + which * 4 + h]; }
#pragma unroll
        for (int i = 0; i < 8; ++i) { const int idx = tid + 512 * i, row = idx >> 5, c16 = idx & 31;
            const v4u v = *(const v4u*)(proj + (size_t)(tok0 + row) * MP + 1024 + h * 256 + c16 * 8);
            *(LAS v4u*)(lds + ML_V + vt16(row, c16, 512)) = v; }
        __syncthreads();
        if (wave < 2) {
            const int dir = wave, s0 = dir ? 127 - 2 * lane : 2 * lane, s1 = dir ? 126 - 2 * lane : 2 * lane + 1;
            const float li0 = gs[dir * 256 + s0], lf0 = gs[dir * 256 + 128 + s0], li1 = gs[dir * 256 + s1], lf1 = gs[dir * 256 + 128 + s1];
            const float pair = lf0 + lf1, inc = wscan_add(pair), exc = inc - pair, b0 = exc + lf0, b1 = inc;
            const float bl = lane63(inc);
            const float a0 = bl - b0 + li0, a1 = bl - b1 + li1;
            const float am = wave_max(fmaxf(a0, a1));
            wv[dir * 128 + s0] = __expf(a0 - am); wv[dir * 128 + s1] = __expf(a1 - am);
            if (lane == 0) { blam[((size_t)(dir * 8 + bh) * 64 + c) * 2] = bl; blam[((size_t)(dir * 8 + bh) * 64 + c) * 2 + 1] = am; }
        }
        __syncthreads();
#pragma unroll
        for (int i = 0; i < 4; ++i) { const int idx = tid + 512 * i, row = idx >> 4, c16 = idx & 15;
            const v4u kv = *(const v4u*)(proj + (size_t)(tok0 + row) * MP + 512 + h * 128 + c16 * 8);
            float f[8]; unpack8(kv, f);
            const float w0 = wv[row], w1 = wv[128 + row];
            v4u a, bb;
            a.x = cvtpk(f[0] * w0, f[1] * w0); a.y = cvtpk(f[2] * w0, f[3] * w0); a.z = cvtpk(f[4] * w0, f[5] * w0); a.w = cvtpk(f[6] * w0, f[7] * w0);
            bb.x = cvtpk(f[0] * w1, f[1] * w1); bb.y = cvtpk(f[2] * w1, f[3] * w1); bb.z = cvtpk(f[4] * w1, f[5] * w1); bb.w = cvtpk(f[6] * w1, f[7] * w1);
            *(LAS v4u*)(lds + ML_A + vt16(row, c16, 256)) = a; *(LAS v4u*)(lds + ML_B + vt16(row, c16, 256)) = bb; }
        __syncthreads();
        if (tid < 256) {
            const int dir = tid >> 7, d = tid & 127; float s = 0.f;
            LAS const unsigned char* kb = lds + (dir ? ML_B : ML_A);
#pragma unroll 8
            for (int r = 0; r < 128; ++r) s += bf2f(*(LAS const unsigned short*)(kb + vt16(r, d >> 3, 256) + (d & 7) * 2));
            nbuf[((size_t)(dir * 8 + bh) * 64 + c) * 128 + d] = s;
        }
        f32x16 af[4], ab[4];
#pragma unroll
        for (int e = 0; e < 4; ++e) { af[e] = (f32x16){}; ab[e] = (f32x16){}; }
        const int q4 = (lane & 15) >> 2, lo8 = 8 * (lane & 1), cq = 2 * ((lane >> 4) & 1) + ((lane & 3) >> 1);
#pragma unroll 2
        for (int ks = 0; ks < 8; ++ks) {
            const int R = 16 * ks + 8 * hh + q4;
            const int cha = 4 * db + cq;
            const bf16x8 Af = cat8(tr_read(lds + ML_A + vt16(R, cha, 256) + lo8), tr_read(lds + ML_A + vt16(R + 4, cha, 256) + lo8));
            const bf16x8 Ab = cat8(tr_read(lds + ML_B + vt16(R, cha, 256) + lo8), tr_read(lds + ML_B + vt16(R + 4, cha, 256) + lo8));
#pragma unroll
            for (int eb = 0; eb < 4; ++eb) {
                const int chv = 4 * (4 * eh + eb) + cq;
                const bf16x8 Bv = cat8(tr_read(lds + ML_V + vt16(R, chv, 512) + lo8), tr_read(lds + ML_V + vt16(R + 4, chv, 512) + lo8));
                af[eb] = __builtin_amdgcn_mfma_f32_32x32x16_bf16(Af, Bv, af[eb], 0, 0, 0);
                ab[eb] = __builtin_amdgcn_mfma_f32_32x32x16_bf16(Ab, Bv, ab[eb], 0, 0, 0);
            }
        }
#pragma unroll
        for (int dir = 0; dir < 2; ++dir) {
            char* ob = (char*)(kvb + ((size_t)(dir * 8 + bh) * 64 + c) * 32768 + (size_t)(db * 8 + 4 * eh) * 1024);
            const unsigned olo = (unsigned)lane * 16u;
#pragma unroll
            for (int eb = 0; eb < 4; ++eb)
#pragma unroll
                for (int k2 = 0; k2 < 2; ++k2) {
                    const f32x16& a = dir ? ab[eb] : af[eb];
                    v4u w; w.x = cvtpk(a[8 * k2 + 0], a[8 * k2 + 1]); w.y = cvtpk(a[8 * k2 + 2], a[8 * k2 + 3]); w.z = cvtpk(a[8 * k2 + 4], a[8 * k2 + 5]); w.w = cvtpk(a[8 * k2 + 6], a[8 * k2 + 7]);
                    *(v4u*)(ob + (unsigned)((eb * 2 + k2) * 1024) + olo) = w;
                }
        }
        __syncthreads();
    }
}

__device__ __forceinline__ void mlstm_scan_phase(bf16* kvb, float* nbuf, const float* blam, float* mprev, int bx, int G, int tid) {
    for (int u = bx; u < 256; u += G) {
        const int seq = u >> 4, slab = u & 15, dir = seq >> 3;
        bf16* base = kvb + (size_t)seq * 64 * 32768 + (size_t)(slab * 512 + tid) * 4;
        const bool do_n = (slab == 0) && (tid < 128);
        float st[4] = {0.f, 0.f, 0.f, 0.f}, nst = 0.f, m = 0.f;
        for (int cc = 0; cc < 64; cc += 8) {
            v2u ld[8]; float nl[8];
#pragma unroll
            for (int k = 0; k < 8; ++k) { const int c = dir ? 63 - (cc + k) : cc + k; ld[k] = *(const v2u*)(base + (size_t)c * 32768); nl[k] = do_n ? nbuf[((size_t)seq * 64 + c) * 128 + tid] : 0.f; }
#pragma unroll
            for (int k = 0; k < 8; ++k) {
                const int c = dir ? 63 - (cc + k) : cc + k;
                const float bl = blam[((size_t)seq * 64 + c) * 2], am = blam[((size_t)seq * 64 + c) * 2 + 1];
                const float mn = fmaxf(bl + m, am), sp = __expf(bl + m - mn), sc = __expf(am - mn);
                v2u o; o.x = cvtpk(st[0], st[1]); o.y = cvtpk(st[2], st[3]);
                *(v2u*)(base + (size_t)c * 32768) = o;
                st[0] = sp * st[0] + sc * __uint_as_float(ld[k].x << 16); st[1] = sp * st[1] + sc * __uint_as_float(ld[k].x & 0xffff0000u);
                st[2] = sp * st[2] + sc * __uint_as_float(ld[k].y << 16); st[3] = sp * st[3] + sc * __uint_as_float(ld[k].y & 0xffff0000u);
                if (do_n) { nbuf[((size_t)seq * 64 + c) * 128 + tid] = nst; nst = sp * nst + sc * nl[k]; }
                if (slab == 0 && tid == 0) mprev[seq * 64 + c] = m;
                m = mn;
            }
        }
    }
}

__device__ __forceinline__ void mlstm_out_phase(const bf16* proj, const float* gates, const bf16* kvb, const float* nbuf, const float* mprev, const float* nw, bf16* hs,
                                                LAS unsigned char* lds, int vcu, int G, int tid) {
    const int wave = __builtin_amdgcn_readfirstlane(tid >> 6), tb = wave & 3, eh = wave >> 2;
    LAS float* gs = (LAS float*)(lds + XTRA_OFF);
    LAS float* ap = gs + 512; LAS float* Mx = gs + 768; LAS float* inr = gs + 1024; LAS float* cl = gs + 1280; LAS float* qnp = gs + 1536; LAS float* npv = gs + 2560;
    for (int item = vcu; item < 512; item += G) {
        int tid_i = tid; asm volatile("" : "+v"(tid_i));
        const int tid = tid_i, lane = tid & 63, r32 = lane & 31, hh = lane >> 5;
        const int bh = item >> 6, c = item & 63, b = bh >> 2, h = bh & 3, tok0 = b * SEQ + c * 128;
        { const int s = tid & 127, which = tid >> 7; gs[which * 128 + s] = gates[(size_t)(tok0 + s) * 16 + which * 4 + h]; }
        if (tid < 256) npv[tid] = nbuf[((size_t)((tid >> 7) * 8 + bh) * 64 + c) * 128 + (tid & 127)];
#pragma unroll
        for (int i = 0; i < 4; ++i) { const int idx = tid + 512 * i, row = idx >> 4, c16 = idx & 15;
            const bf16* src = proj + (size_t)(tok0 + row) * MP + h * 128 + c16 * 8;
            const v4u q = *(const v4u*)src, k = *(const v4u*)(src + 512);
            *(LAS v2u*)(lds + ML_A + qk8(row, 2 * c16)) = (v2u){q.x, q.y}; *(LAS v2u*)(lds + ML_A + qk8(row, 2 * c16 + 1)) = (v2u){q.z, q.w};
            *(LAS v2u*)(lds + ML_B + qk8(row, 2 * c16)) = (v2u){k.x, k.y}; *(LAS v2u*)(lds + ML_B + qk8(row, 2 * c16 + 1)) = (v2u){k.z, k.w}; }
#pragma unroll
        for (int i = 0; i < 8; ++i) { const int idx = tid + 512 * i, row = idx >> 5, c16 = idx & 31;
            const v4u v = *(const v4u*)(proj + (size_t)(tok0 + row) * MP + 1024 + h * 256 + c16 * 8);
            *(LAS v4u*)(lds + ML_V + vt16(row, c16, 512)) = v; }
        __syncthreads();
        if (wave < 2) {
            const int dir = wave, s0 = dir ? 127 - 2 * lane : 2 * lane, s1 = dir ? 126 - 2 * lane : 2 * lane + 1;
            const float li0 = gs[dir * 256 + s0], lf0 = gs[dir * 256 + 128 + s0], li1 = gs[dir * 256 + s1], lf1 = gs[dir * 256 + 128 + s1];
            const float pair = lf0 + lf1, inc = wscan_add(pair), exc = inc - pair, b0 = exc + lf0, b1 = inc;
            const float ap0 = li0 - b0, ap1 = li1 - b1;
            const float incm = wscan_max(fmaxf(ap0, ap1));
            const float excm = wave_shr1(incm, -INFINITY);
            const float pm0 = fmaxf(excm, ap0), pm1 = incm;
            const float mp = mprev[(dir * 8 + bh) * 64 + c];
            const float M0 = fmaxf(mp, pm0), M1 = fmaxf(mp, pm1);
            ap[dir * 128 + s0] = ap0; ap[dir * 128 + s1] = ap1;
            Mx[dir * 128 + s0] = M0; Mx[dir * 128 + s1] = M1;
            inr[dir * 128 + s0] = __expf(mp - M0); inr[dir * 128 + s1] = __expf(mp - M1);
            cl[dir * 128 + s0] = __expf(-(b0 + M0)); cl[dir * 128 + s1] = __expf(-(b1 + M1));
        }
        {
            const int t = tid & 127, qt = tid >> 7; float s0 = 0.f, s1 = 0.f;
#pragma unroll
            for (int g8 = 0; g8 < 8; ++g8) {
                const v2u w = *(LAS const v2u*)(lds + ML_A + qk8(t, 8 * qt + g8));
                const int d = 32 * qt + 4 * g8;
                const float q0 = __uint_as_float(w.x << 16), q1 = __uint_as_float(w.x & 0xffff0000u), q2 = __uint_as_float(w.y << 16), q3 = __uint_as_float(w.y & 0xffff0000u);
                s0 += q0 * npv[d] + q1 * npv[d + 1] + q2 * npv[d + 2] + q3 * npv[d + 3];
                s1 += q0 * npv[128 + d] + q1 * npv[128 + d + 1] + q2 * npv[128 + d + 2] + q3 * npv[128 + d + 3];
            }
            qnp[(qt * 2 + 0) * 128 + t] = s0; qnp[(qt * 2 + 1) * 128 + t] = s1;
        }
        __syncthreads();
        bf16x8 qf[8];
#pragma unroll
        for (int ks = 0; ks < 8; ++ks) {
            const v2u lo = *(LAS const v2u*)(lds + ML_A + qk8(32 * tb + r32, 4 * ks + hh)), hi = *(LAS const v2u*)(lds + ML_A + qk8(32 * tb + r32, 4 * ks + 2 + hh));
            qf[ks] = __builtin_bit_cast(bf16x8, (v4u){lo.x, lo.y, hi.x, hi.y});
        }
        const int q4 = (lane & 15) >> 2, lo8 = 8 * (lane & 1), cq = 2 * ((lane >> 4) & 1) + ((lane & 3) >> 1);
        const int tl = 32 * tb + r32;
        bf16x8 pa[5][2]; float rs0 = 0.f, rs1 = 0.f;
        bf16x8 kfa[8], kfb[8];
#define ML_LOADK(i_, dst) do { const int sb_ = (i_) - (((i_) > tb) ? 1 : 0); _Pragma("unroll") for (int ks = 0; ks < 8; ++ks) { \
            const v2u lo = *(LAS const v2u*)(lds + ML_B + qk8(32 * sb_ + r32, 4 * ks + hh)), hi = *(LAS const v2u*)(lds + ML_B + qk8(32 * sb_ + r32, 4 * ks + 2 + hh)); \
            dst[ks] = __builtin_bit_cast(bf16x8, (v4u){lo.x, lo.y, hi.x, hi.y}); } } while (0)
        ML_LOADK(0, kfa);
#pragma unroll
        for (int i = 0; i < 5; ++i) {
            const int dir = (i > tb) ? 1 : 0, sb = i - dir;
            if (i < 4) { if (i & 1) { ML_LOADK(i + 1, kfa); } else { ML_LOADK(i + 1, kfb); } }
            __builtin_amdgcn_sched_barrier(0);
            f32x16 x = (f32x16){};
#pragma unroll
            for (int ks = 0; ks < 8; ++ks) x = __builtin_amdgcn_mfma_f32_32x32x16_bf16((i & 1) ? kfb[ks] : kfa[ks], qf[ks], x, 0, 0, 0);
            const float Mt = Mx[dir * 128 + tl];
            float rsum = 0.f;
#pragma unroll
            for (int r = 0; r < 16; ++r) {
                const int sl = 32 * sb + crow(r, hh);
                const bool ok = dir ? (sl >= tl) : (sl <= tl);
                const float p = ok ? x[r] * __expf(ap[dir * 128 + sl] - Mt) : 0.f;
                x[r] = p; rsum += p;
            }
            if (dir) rs1 += rsum; else rs0 += rsum;
#pragma unroll
            for (int s2 = 0; s2 < 2; ++s2) { v4u w; w.x = cvtpk(x[8 * s2 + 0], x[8 * s2 + 1]); w.y = cvtpk(x[8 * s2 + 2], x[8 * s2 + 3]); w.z = cvtpk(x[8 * s2 + 4], x[8 * s2 + 5]); w.w = cvtpk(x[8 * s2 + 6], x[8 * s2 + 7]); pa[i][s2] = __builtin_bit_cast(bf16x8, w); }
        }
#undef ML_LOADK
        rs0 = xhalf_sum(rs0); rs1 = xhalf_sum(rs1);
        float rd0, rd1, qs0, qs1;
        { const float qn0 = (qnp[0 * 128 + tl] + qnp[2 * 128 + tl]) + (qnp[4 * 128 + tl] + qnp[6 * 128 + tl]);
          const float qn1 = (qnp[1 * 128 + tl] + qnp[3 * 128 + tl]) + (qnp[5 * 128 + tl] + qnp[7 * 128 + tl]);
          const float in0 = inr[tl], in1 = inr[128 + tl];
          rd0 = 1.0f / fmaxf(fabsf(rs0 + in0 * qn0), cl[tl]); rd1 = 1.0f / fmaxf(fabsf(rs1 + in1 * qn1), cl[128 + tl]);
          qs0 = in0 * rd0; qs1 = in1 * rd1; }
#pragma unroll
        for (int i = 0; i < 5; ++i) {
            const float rd = (i > tb) ? rd1 : rd0;
#pragma unroll
            for (int s2 = 0; s2 < 2; ++s2) { float f[8]; unpack8(__builtin_bit_cast(v4u, pa[i][s2]), f);
                v4u w; w.x = cvtpk(f[0] * rd, f[1] * rd); w.y = cvtpk(f[2] * rd, f[3] * rd); w.z = cvtpk(f[4] * rd, f[5] * rd); w.w = cvtpk(f[6] * rd, f[7] * rd); pa[i][s2] = __builtin_bit_cast(bf16x8, w); }
        }
        f32x16 acc[4];
#pragma unroll
        for (int e = 0; e < 4; ++e) acc[e] = (f32x16){};
        {
            bf16x8 vfa[4], vfb[4];
#define ML_LOADV(st_, dst) do { const int i_ = (st_) >> 1, sb_ = i_ - ((i_ > tb) ? 1 : 0), R0_ = 32 * sb_ + 16 * ((st_) & 1) + 4 * hh + q4; _Pragma("unroll") for (int eb = 0; eb < 4; ++eb) { \
            const int chv_ = 4 * (4 * eh + eb) + cq; dst[eb] = cat8(tr_read(lds + ML_V + vt16(R0_, chv_, 512) + lo8), tr_read(lds + ML_V + vt16(R0_ + 8, chv_, 512) + lo8)); } } while (0)
            ML_LOADV(0, vfa);
#pragma unroll
            for (int st = 0; st < 10; ++st) {
                if (st < 9) { if (st & 1) { ML_LOADV(st + 1, vfa); } else { ML_LOADV(st + 1, vfb); } }
                __builtin_amdgcn_sched_barrier(0);
#pragma unroll
                for (int eb = 0; eb < 4; ++eb) acc[eb] = __builtin_amdgcn_mfma_f32_32x32x16_bf16(pa[st >> 1][st & 1], (st & 1) ? vfb[eb] : vfa[eb], acc[eb], 0, 0, 0);
                __builtin_amdgcn_sched_barrier(0);
            }
#undef ML_LOADV
        }
        {
            const char* cb0 = (const char*)(kvb + ((size_t)(0 * 8 + bh) * 64 + c) * 32768 + (size_t)eh * 4096);
            const char* cb1 = (const char*)(kvb + ((size_t)(1 * 8 + bh) * 64 + c) * 32768 + (size_t)eh * 4096);
            const unsigned clo = (unsigned)lane * 16u;
            constexpr int NSET = 5;
            bf16x8 cf[NSET][4];
#define ML_LOADC(ix_, dst) _Pragma("unroll") for (int eb = 0; eb < 4; ++eb) dst[eb] = *(const bf16x8*)((((ix_) >> 3) ? cb1 : cb0) + (unsigned)((((((ix_) & 7) >> 1) * 8 + eb) * 2 + ((ix_) & 1)) * 1024) + clo)
#pragma unroll
            for (int p = 0; p < NSET - 1; ++p) { ML_LOADC(p, cf[p]); }
#pragma unroll
            for (int ix = 0; ix < 16; ++ix) {
                if (ix + NSET - 1 < 16) { ML_LOADC(ix + NSET - 1, cf[(ix + NSET - 1) % NSET]); }
                const float qsc = (ix >> 3) ? qs1 : qs0;
                float f[8]; unpack8(__builtin_bit_cast(v4u, qf[ix & 7]), f);
                v4u w; w.x = cvtpk(f[0] * qsc, f[1] * qsc); w.y = cvtpk(f[2] * qsc, f[3] * qsc); w.z = cvtpk(f[4] * qsc, f[5] * qsc); w.w = cvtpk(f[6] * qsc, f[7] * qsc);
                const bf16x8 qsv = __builtin_bit_cast(bf16x8, w);
                __builtin_amdgcn_sched_barrier(0);
#pragma unroll
                for (int eb = 0; eb < 4; ++eb) acc[eb] = __builtin_amdgcn_mfma_f32_32x32x16_bf16(qsv, cf[ix % NSET][eb], acc[eb], 0, 0, 0);
                __builtin_amdgcn_sched_barrier(0);
            }
#undef ML_LOADC
        }
        v2u ogr[16];
#pragma unroll
        for (int rr = 0; rr < 16; ++rr) ogr[rr] = *(const v2u*)(proj + (size_t)(tok0 + 16 * wave + rr) * MP + 2048 + h * 256 + lane * 4);
        const f32x4 w4 = *(const f32x4*)(nw + h * 256 + lane * 4);
        __syncthreads();
#pragma unroll
        for (int e = 0; e < 4; ++e)
#pragma unroll
            for (int r = 0; r < 16; ++r) *(LAS float*)(lds + (32 * tb + crow(r, hh)) * 1024 + (128 * eh + 32 * e + r32) * 4) = acc[e][r];
        __syncthreads();
#pragma unroll
        for (int rr = 0; rr < 16; ++rr) {
            const int t = 16 * wave + rr;
            const f32x4 v = *(LAS const f32x4*)(lds + t * 1024 + lane * 16);
            const float ss = wave_sum((v.x * v.x + v.y * v.y) + (v.z * v.z + v.w * v.w));
            const float rn = rsqrtf(ss * (1.0f / 256.0f) + EPS);
            const v2u og = ogr[rr];
            const float o0 = __uint_as_float(og.x << 16), o1 = __uint_as_float(og.x & 0xffff0000u), o2 = __uint_as_float(og.y << 16), o3 = __uint_as_float(og.y & 0xffff0000u);
            v2u out;
            out.x = cvtpk(v.x * rn * w4.x / (1.0f + __expf(-o0)), v.y * rn * w4.y / (1.0f + __expf(-o1)));
            out.y = cvtpk(v.z * rn * w4.z / (1.0f + __expf(-o2)), v.w * rn * w4.w / (1.0f + __expf(-o3)));
            *(v2u*)(hs + (size_t)(tok0 + t) * D + h * 256 + lane * 4) = out;
        }
        __syncthreads();
    }
}

#ifndef OPT_ATTN
#define OPT_ATTN 1
#endif
#ifndef OPT_MLSTM
#define OPT_MLSTM 1
#endif
#ifndef PROBE_DUP
#define PROBE_DUP 0
#endif
#ifndef ONE_LAUNCH
#define ONE_LAUNCH 1
#endif
constexpr int RTAB_OFF = LDSCTL_OFF + 1024;
typedef unsigned v2u_t __attribute__((ext_vector_type(2)));
__global__ void __launch_bounds__(NWAVES * 64, 2) mk_fwd(Args args) {
    extern __shared__ __attribute__((aligned(16))) unsigned char lds_raw[];
    LAS unsigned char* lds = (LAS unsigned char*)lds_raw;
    volatile LAS unsigned* MISC = (volatile LAS unsigned*)(lds + MISC_OFF);
    const int tid = threadIdx.x; const int wave_s = __builtin_amdgcn_readfirstlane(tid >> 6);
    const int G = gridDim.x; const int bx = blockIdx.x; const int vcu = (G % 8 == 0) ? (bx % 8) * (G / 8) + bx / 8 : bx;
    Ptrs P;
    P.x = args.in[0]; P.pos = (const int*)args.in[1]; P.norm_mix_w = args.in[2]; P.norm_ffn_w = args.in[3]; P.norm_final_w = args.in[4]; P.mlstm_w_in = args.in[5];
    P.mlstm_b_gate = args.in[6]; P.mlstm_norm_w = args.in[7]; P.mlstm_w_out = args.in[8]; P.attn_w_in = args.in[9]; P.attn_sink = args.in[10]; P.attn_w_out = args.in[11];
    P.ffn_w_in = args.in[12]; P.ffn_w_out = args.in[13]; P.out = args.out; P.ws = args.ws;
    unsigned char* ws = args.ws;
    gu32* ctl = (gu32*)(ws + WS_CTL);
    for (int u = tid; u < (LDS_BYTES - LDSCTL_OFF) / 4; u += NWAVES * 64) ((LAS unsigned*)(lds + LDSCTL_OFF))[u] = 0u;
    __syncthreads();
    const int lo = args.ph_lo, hi = args.ph_hi;
    XcdBarrier bar; bar.bar = (unsigned*)(ctl + CW_BAR); bar.x = 0; bar.st = nullptr;
    if (hi - lo > 1) bar = xcd_barrier_post((unsigned*)(ctl + CW_BAR), MISC + 8);
    int ph = 0;
#define PH_ON (ph >= lo && ph < hi)
#define PH_IDS int tid_p; asm volatile("v_mbcnt_lo_u32_b32 %0, -1, 0\n\tv_mbcnt_hi_u32_b32 %0, -1, %0" : "=v"(tid_p)); tid_p += wave_s * 64; asm volatile("" : "+v"(tid_p)); const int lane = tid_p & 63, wave = __builtin_amdgcn_readfirstlane(tid_p >> 6); (void)lane; (void)wave
#define REP(bit) for (int rep_ = 0; rep_ < 1 + ((args.dup >> (bit)) & 1); ++rep_)
#define PH_END do { if (ph >= lo && ph + 1 < hi) xcd_barrier(bar); ++ph; } while (0)

    bf16* xb = (bf16*)(ws + WS_XB); bf16* hs = (bf16*)(ws + WS_HS); bf16* proj = (bf16*)(ws + WS_PROJ);
    float* part = (float*)(ws + WS_PART);
    const float* cosT = (const float*)(ws + WS_ROPE); const float* sinT = cosT + (size_t)M * 32;

    if (PH_ON) REP(4) { PH_IDS; p0_prologue(P, lds, vcu, G, wave, lane); }
    PH_END;
#if PROBE_DUP & 64
    if (hi - lo > 1) for (int xb_ = 0; xb_ < 10; ++xb_) xcd_barrier(bar);
#endif

    for (int L = 0; L < 4; ++L) {
        const int j = L >> 1;
        if ((L & 1) == 0) {
            if (PH_ON) {
                { PH_IDS; for (int gb = bx; gb < M / 64; gb += G) gates_step(P, j, lds, gb, wave, lane); }
                pg8::Gemm g{xb, (const bf16*)(ws + W_MIN) + (size_t)j * MP * D, M, MP, D}; pg8::StaticOrder S; S.init(M, MP, G, bx);
                { PH_IDS; pg8::rstd_table_fill(part, S, (LAS float*)(lds + RTAB_OFF), tid_p); }
                pg8::EpiProj<false> E{proj, MP, (const LAS float*)(lds + RTAB_OFF), nullptr, nullptr};
                REP(1) pg8::gemm_phase<pg8::EpiProj<false>, pg8::StaticOrder, true, true>(lds + RING_OFF, g, S, E, wave_s);
            }
            PH_END;
            if (PH_ON) REP(2) { PH_IDS; mlstm_chunk_phase(proj, (const float*)(ws + WS_GATES), (bf16*)(ws + WS_KV), (float*)(ws + WS_NBUF), (float*)(ws + WS_SMALL), lds, vcu, G, tid_p); }
            PH_END;
            if (PH_ON) { PH_IDS; mlstm_scan_phase((bf16*)(ws + WS_KV), (float*)(ws + WS_NBUF), (const float*)(ws + WS_SMALL), (float*)(ws + WS_SMALL + 16384), bx, G, tid_p); }
            PH_END;
            if (PH_ON) REP(5) { PH_IDS; mlstm_out_phase(proj, (const float*)(ws + WS_GATES), (const bf16*)(ws + WS_KV), (const float*)(ws + WS_NBUF), (const float*)(ws + WS_SMALL + 16384), P.mlstm_norm_w + j * D, hs, lds, vcu, G, tid_p); }
            PH_END;
        } else {
            if (PH_ON) {
                pg8::Gemm g{xb, (const bf16*)(ws + W_AIN) + (size_t)j * AW * D, M, AW, D}; pg8::StaticOrder S; S.init(M, AW, G, bx);
                { PH_IDS; pg8::rstd_table_fill(part, S, (LAS float*)(lds + RTAB_OFF), tid_p); }
                pg8::EpiProj<true> E{proj, AW, (const LAS float*)(lds + RTAB_OFF), cosT, sinT};
                REP(1) pg8::gemm_phase<pg8::EpiProj<true>, pg8::StaticOrder, true, true>(lds + RING_OFF, g, S, E, wave_s);
            }
            PH_END;
            if (PH_ON) REP(3) { PH_IDS; attn_phase(proj, P.attn_sink + j * 16, hs, lds, vcu, G, tid_p); }
#if PROBE_DUP & 512
            if (PH_ON) { PH_IDS; attn_phase(proj, P.attn_sink + j * 16, hs, lds, vcu, G, tid_p, 1); }
#endif
#if PROBE_DUP & 1024
            if (PH_ON) { PH_IDS; attn_phase(proj, P.attn_sink + j * 16, hs, lds, vcu, G, tid_p, 2); }
#endif
#if PROBE_DUP & 2048
            if (PH_ON) { PH_IDS; attn_phase(proj, P.attn_sink + j * 16, hs, lds, vcu, G, tid_p, 3); }
#endif
            PH_END;
        }
        if (PH_ON) {
            const bf16* wo = (L & 1) ? (const bf16*)(ws + W_AOUT) + (size_t)j * D * D : (const bf16*)(ws + W_MOUT) + (size_t)j * D * D;
            pg8::Gemm g{hs, wo, M, D, D}; pg8::StaticOrder S; S.init(M, D, G, bx);
#if PROBE_DUP & 256
            { pg8::EpiNull EN; pg8::gemm_phase<pg8::EpiNull, pg8::StaticOrder, true, true>(lds + RING_OFF, g, S, EN, wave_s); }
#endif
            pg8::EpiResid E{xb, part};
            pg8::gemm_phase<pg8::EpiResid, pg8::StaticOrder, true, true>(lds + RING_OFF, g, S, E, wave_s);
        }
        PH_END;
        if (PH_ON) {
            pg8::Gemm g{xb, (const bf16*)(ws + W_FIN) + (size_t)L * 2 * DFF * D, M, 2 * DFF, D}; pg8::StaticOrder S; S.init(M, 2 * DFF, G, bx);
#if PROBE_DUP & 8192
            { pg8::EpiSwiGLU EN{proj, DFF, nullptr}; pg8::gemm_phase<pg8::EpiSwiGLU, pg8::StaticOrder, true, true>(lds + RING_OFF, g, S, EN, wave_s); }
#endif
#if PROBE_DUP & 4096
            { pg8::EpiNull EN; pg8::gemm_phase<pg8::EpiNull, pg8::StaticOrder, true, true>(lds + RING_OFF, g, S, EN, wave_s); }
#endif
            { PH_IDS; pg8::rstd_table_fill(part, S, (LAS float*)(lds + RTAB_OFF), tid_p); }
            pg8::EpiSwiGLU E{proj, DFF, (const LAS float*)(lds + RTAB_OFF)};
            REP(0) pg8::gemm_phase<pg8::EpiSwiGLU, pg8::StaticOrder, true, true>(lds + RING_OFF, g, S, E, wave_s);
        }
        PH_END;
        if (PH_ON) {
            pg8::Gemm g{proj, (const bf16*)(ws + W_FOUT) + (size_t)L * D * DFF, M, D, DFF}; pg8::StaticOrder S; S.init(M, D, G, bx);
#if PROBE_DUP & 128
            { pg8::EpiNull EN; pg8::gemm_phase<pg8::EpiNull, pg8::StaticOrder, true, true>(lds + RING_OFF, g, S, EN, wave_s); }
#endif
            pg8::EpiResid E{xb, part};
            pg8::gemm_phase<pg8::EpiResid, pg8::StaticOrder, true, true>(lds + RING_OFF, g, S, E, wave_s);
        }
        PH_END;
    }
    if (PH_ON) {
        PH_IDS;
        const int gw = vcu * NWAVES + wave, NGW = G * NWAVES;
        for (int m = gw; m < M; m += NGW) {
            float s = lane < 16 ? part[(size_t)m * 16 + lane] : 0.f;
            s = wave_sum(s);
            const float rstd = rsqrtf(s * (1.0f / 1024.0f) + EPS);
            GAS f32x4* orow = (GAS f32x4*)(P.out + (size_t)m * D) + lane;
            const GAS f32x4* wr = (const GAS f32x4*)P.norm_final_w + lane;
            const GAS v2u_t* xr = (const GAS v2u_t*)(xb + (size_t)m * D) + lane;
#pragma unroll
            for (int jj = 0; jj < 4; ++jj) { const v2u_t xv = xr[64 * jj]; const f32x4 w = wr[64 * jj];
                f32x4 v = {__uint_as_float(xv.x << 16), __uint_as_float(xv.x & 0xffff0000u), __uint_as_float(xv.y << 16), __uint_as_float(xv.y & 0xffff0000u)};
                v = v * rstd * w; orow[64 * jj] = v; }
        }
    }
    PH_END;
}

#if !ONE_LAUNCH
namespace nv {
constexpr int TCH = 32;
__global__ void __launch_bounds__(272) k_mlstm_rec(const bf16* __restrict__ proj, const float* __restrict__ gates, bf16* __restrict__ hf, bf16* __restrict__ hb) {
    __shared__ float sq[TCH][128], sk[TCH][128], sv[TCH][17], sli[TCH], slf[TCH];
    __shared__ float red[2][16][17];
    const int es = blockIdx.x, h = blockIdx.y, b = blockIdx.z >> 1, dir = blockIdx.z & 1;
    const int tid = threadIdx.x, e = tid % 17, dg = tid / 17;
    float C[8];
#pragma unroll
    for (int j = 0; j < 8; ++j) C[j] = 0.f;
    float m = 0.f;
    bf16* hout = dir ? hb : hf;
    int par = 0;
    for (int c0 = 0; c0 < SEQ; c0 += TCH) {
        __syncthreads();
        for (int i = tid; i < TCH * 128; i += 272) {
            const int tt = i >> 7, d = i & 127;
            const int t = dir ? (SEQ - 1 - (c0 + tt)) : (c0 + tt);
            const bf16* row = proj + (size_t)(b * SEQ + t) * MP;
            sq[tt][d] = bf2f(row[h * 128 + d]);
            sk[tt][d] = bf2f(row[512 + h * 128 + d]);
        }
        for (int i = tid; i < TCH * 17; i += 272) {
            const int tt = i / 17, ee = i % 17;
            const int t = dir ? (SEQ - 1 - (c0 + tt)) : (c0 + tt);
            const bf16* row = proj + (size_t)(b * SEQ + t) * MP;
            sv[tt][ee] = ee < 16 ? bf2f(row[1024 + h * 256 + es * 16 + ee]) : 1.0f;
        }
        if (tid < TCH) {
            const int t = dir ? (SEQ - 1 - (c0 + tid)) : (c0 + tid);
            const float* row = gates + (size_t)(b * SEQ + t) * 16;
            sli[tid] = row[(dir ? 8 : 0) + h];
            slf[tid] = row[(dir ? 12 : 4) + h];
        }
        __syncthreads();
        for (int tt = 0; tt < TCH; ++tt) {
            const float li = sli[tt], lf = slf[tt];
            const float mn = fmaxf(lf + m, li);
            const float fs = expf(lf + m - mn), is = expf(li - mn);
            m = mn;
            const float vv = sv[tt][e] * is;
            float partv = 0.f;
#pragma unroll
            for (int j = 0; j < 8; ++j) {
                const int d = dg * 8 + j;
                C[j] = fs * C[j] + sk[tt][d] * vv;
                partv += sq[tt][d] * C[j];
            }
            red[par][dg][e] = partv;
            __syncthreads();
            if (tid < 16) {
                float num = 0.f, qn = 0.f;
#pragma unroll
                for (int g = 0; g < 16; ++g) { num += red[par][g][tid]; qn += red[par][g][16]; }
                const float den = fmaxf(fabsf(qn), expf(-m));
                const int t = dir ? (SEQ - 1 - (c0 + tt)) : (c0 + tt);
                hout[(size_t)(b * SEQ + t) * D + h * 256 + es * 16 + tid] = (bf16)f2bf(num / den);
            }
            par ^= 1;
        }
    }
}
__global__ void k_mlstm_post(const bf16* __restrict__ hf, const bf16* __restrict__ hb, const bf16* __restrict__ proj, const float* __restrict__ nw, bf16* __restrict__ out) {
    const int row = blockIdx.x, tid = threadIdx.x, h = tid >> 6, lane = tid & 63;
    const size_t off = (size_t)row * D + h * 256 + lane * 4;
    float v[4]; float s = 0.f;
#pragma unroll
    for (int c = 0; c < 4; ++c) { v[c] = bf2f(hf[off + c]) + bf2f(hb[off + c]); s += v[c] * v[c]; }
    for (int o = 32; o > 0; o >>= 1) s += __shfl_xor(s, o);
    const float r = rsqrtf(s * (1.0f / 256.0f) + EPS);
#pragma unroll
    for (int c = 0; c < 4; ++c) {
        const float og = bf2f(proj[(size_t)row * MP + 2048 + h * 256 + lane * 4 + c]);
        out[off + c] = (bf16)f2bf(v[c] * r * nw[h * 256 + lane * 4 + c] / (1.0f + expf(-og)));
    }
}
__global__ void __launch_bounds__(64) k_attn(const bf16* __restrict__ proj, const float* __restrict__ sink, bf16* __restrict__ out) {
    const int idx = blockIdx.x * 64 + threadIdx.x;
    const int hq = idx / M, tok = idx % M;
    const int b = tok / SEQ, i = tok % SEQ, hkv = hq >> 2;
    float q[64], acc[64];
    const bf16* qp = proj + (size_t)tok * AW + hq * 64;
#pragma unroll
    for (int d = 0; d < 64; ++d) { q[d] = bf2f(qp[d]); acc[d] = 0.f; }
    float m = sink[hq], l = 1.0f;
    const int j0 = max(0, i - 128), j1 = min(SEQ - 1, i + 128);
    for (int jx = j0; jx <= j1; ++jx) {
        const bf16* kp = proj + (size_t)(b * SEQ + jx) * AW + 1024 + hkv * 64;
        const bf16* vp = kp + 256;
        float s = 0.f;
#pragma unroll
        for (int d = 0; d < 64; ++d) s += q[d] * bf2f(kp[d]);
        if (s > m) {
            const float f = expf(m - s);
            l *= f;
#pragma unroll
            for (int d = 0; d < 64; ++d) acc[d] *= f;
            m = s;
        }
        const float p = expf(s - m);
        l += p;
#pragma unroll
        for (int d = 0; d < 64; ++d) acc[d] += p * bf2f(vp[d]);
    }
    const float rl = 1.0f / l;
    bf16* op = out + (size_t)tok * D + hq * 64;
#pragma unroll
    for (int d = 0; d < 64; ++d) op[d] = (bf16)f2bf(acc[d] * rl);
}
}
#endif

extern "C" void kernel_launch(void* const* d_in, const int* in_sizes, int n_in, void* d_out, int out_size, void* d_ws, size_t ws_size, hipStream_t stream) {
    static int grid = 0;
    if (grid == 0) {
        int dev = 0, cus = 0;
        if (hipGetDevice(&dev) != hipSuccess || hipDeviceGetAttribute(&cus, hipDeviceAttributeMultiprocessorCount, dev) != hipSuccess) { fprintf(stderr, "kernel_launch: device query failed\n"); grid = -1; return; }
        if (hipFuncSetAttribute((const void*)mk_fwd, hipFuncAttributeMaxDynamicSharedMemorySize, LDS_BYTES) != hipSuccess) { fprintf(stderr, "kernel_launch: hipFuncSetAttribute failed\n"); grid = -1; return; }
        if (ws_size < WS_END) { fprintf(stderr, "kernel_launch: workspace too small: %zu < %zu\n", ws_size, (size_t)WS_END); grid = -1; return; }
        (void)hipGetLastError();
        grid = cus;
    }
    if (grid < 0) return;
    (void)hipMemsetAsync((char*)d_ws + WS_CTL, 0, CTL_ZERO_BYTES, stream);
    Args a{};
    for (int i = 0; i < 14; ++i) a.in[i] = (const float*)d_in[i];
    a.out = (float*)d_out; a.ws = (unsigned char*)d_ws; a.dup = PROBE_DUP;
    unsigned char* ws = (unsigned char*)d_ws;
    int ph = 0;
    auto launch = [&](int lo, int hi) { a.ph_lo = lo; a.ph_hi = hi; hipLaunchKernelGGL(mk_fwd, dim3(grid), dim3(NWAVES * 64), LDS_BYTES, stream, a); };
#if ONE_LAUNCH
    launch(0, 1000);
#else
    launch(ph, ph + 1); ++ph;
    for (int L = 0; L < 4; ++L) {
        const int j = L >> 1;
        launch(ph, ph + 1); ++ph;
        if ((L & 1) == 0) {
#if OPT_MLSTM
            launch(ph, ph + 1); launch(ph + 1, ph + 2); launch(ph + 2, ph + 3);
#else
            bf16* hf = (bf16*)(ws + WS_KV); bf16* hb = hf + (size_t)M * D;
            hipLaunchKernelGGL(nv::k_mlstm_rec, dim3(16, 4, 4), dim3(272), 0, stream, (const bf16*)(ws + WS_PROJ), (const float*)(ws + WS_GATES), hf, hb);
            hipLaunchKernelGGL(nv::k_mlstm_post, dim3(M), dim3(256), 0, stream, (const bf16*)hf, (const bf16*)hb, (const bf16*)(ws + WS_PROJ), (const float*)d_in[7] + j * D, (bf16*)(ws + WS_HS));
#endif
            ph += 3;
        } else {
#if OPT_ATTN
            launch(ph, ph + 1);
#else
            hipLaunchKernelGGL(nv::k_attn, dim3(M * 16 / 64), dim3(64), 0, stream, (const bf16*)(ws + WS_PROJ), (const float*)d_in[10] + j * 16, (bf16*)(ws + WS_HS));
#endif
            ph += 1;
        }
        launch(ph, ph + 1); ++ph;
        launch(ph, ph + 1); ++ph;
        launch(ph, ph + 1); ++ph;
    }
    launch(ph, ph + 1); ++ph;
#endif
}
```

```cpp
#include <hip/hip_runtime.h>
#include <cstdio>
#include <cstdint>
#include <cmath>
namespace pg8 {
#define PG8_LAS __attribute__((address_space(3)))
typedef unsigned short bf16_t;
typedef short bf16x8 __attribute__((ext_vector_type(8)));
typedef float f32x4 __attribute__((ext_vector_type(4)));
typedef unsigned u32x4 __attribute__((ext_vector_type(4)));
constexpr int BM = 256, BK = 64, HALF = 128, HTB = HALF * BK * 2  , STAGE_BYTES = 8 * HTB, NXCD = 8, WGM = 8;

__host__ __device__ __forceinline__ int lds_byte(int r, int c) { const int st = (r >> 4) * 2 + (c >> 5), rr = r & 15, cc = c & 31, ob = rr * 64 + cc * 2; return st * 1024 + (ob ^ (((ob >> 9) & 1) << 5)); }
__host__ __device__ __forceinline__ void stage_rc(int b, int& R, int& C) { const int st = b / 1024, sb = b % 1024, swz = sb ^ (((sb >> 9) & 1) << 5); R = (st >> 1) * 16 + swz / 64; C = (st & 1) * 32 + (swz % 64) / 2; }
__host__ __device__ __forceinline__ int perm32(int rho) { const int n = rho >> 4, i = rho & 15; return 8 * (i >> 2) + 4 * n + (i & 3); }

struct Unit { int pm, pn, ord; };
struct Gemm { const bf16_t* A; const bf16_t* Bt; int M, N, K; };

struct StaticOrder {
    int nM, nN, nwg, G, c;
    __host__ __device__ void init(int M, int N, int G_, int c_) { nM = M / BM; nN = N / BM; nwg = nM * nN; G = G_; c = c_; }
    __host__ __device__ bool next(int i, Unit& u) const {
        const long L = (long)i * G + c; if (L >= nwg) return false;
        int wgid = (int)L; { const int q = nwg / NXCD, r = nwg % NXCD, xcd = wgid % NXCD, off = wgid / NXCD; wgid = (xcd < r ? xcd * (q + 1) : r * (q + 1) + (xcd - r) * q) + off; }
        const int nig = WGM * nN, gid = wgid / nig, fm = gid * WGM, gsz = (nM - fm) < WGM ? (nM - fm) : WGM;
        u.pm = fm + ((wgid % nig) % gsz); u.pn = (wgid % nig) / gsz; u.ord = i; return true;
    }
    __device__ __forceinline__ void a_ready(const Unit&) const {}
    __device__ __forceinline__ void done(const Unit&) const {}
};

__device__ __forceinline__ unsigned cvt_pk_bf16(float lo, float hi) { unsigned r; asm volatile("v_cvt_pk_bf16_f32 %0, %1, %2" : "=v"(r) : "v"(lo), "v"(hi)); return r; }
typedef float f32x2 __attribute__((ext_vector_type(2)));

constexpr int EP_M = 16384;
constexpr float EP_EPS = 1e-6f;
typedef unsigned u32x2 __attribute__((ext_vector_type(2)));

template <int K> __device__ __forceinline__ float shx(float v) { static_assert(K == 1 || K == 2 || K == 4 || K == 8 || K == 16, "xor mask"); return __int_as_float(__builtin_amdgcn_ds_swizzle(__float_as_int(v), 0x1F | (K << 10))); }
__device__ __forceinline__ float xhalf_sum(float v) { auto rr = __builtin_amdgcn_permlane32_swap(__float_as_uint(v), __float_as_uint(v), false, false); return __uint_as_float(rr[0]) + __uint_as_float(rr[1]); }
__device__ __forceinline__ float xhalf_max(float v) { auto rr = __builtin_amdgcn_permlane32_swap(__float_as_uint(v), __float_as_uint(v), false, false); return fmaxf(__uint_as_float(rr[0]), __uint_as_float(rr[1])); }
__device__ __forceinline__ void row_rstd(const PG8_LAS float* rtab, const Unit& u, int wr, int fr, float (&rs)[2][4]) {
#pragma unroll
    for (int ai = 0; ai < 2; ++ai)
#pragma unroll
        for (int m = 0; m < 4; ++m) rs[ai][m] = rtab[u.ord * 256 + wr * 64 + ai * HALF + m * 16 + fr];
}
template <class Sched> __device__ __forceinline__ void rstd_table_fill(const float* part, const Sched& S, PG8_LAS float* rtab, int tid) {
    Unit u;
    for (int i0 = 0; S.next(i0, u); i0 += 2) {
        const int i = i0 + (tid >> 8);
        if (S.next(i, u)) {
            const int r = tid & 255; const f32x4* p = (const f32x4*)(part + (size_t)(u.pm * BM + r) * 16);
            const f32x4 a = p[0], b = p[1], c = p[2], d = p[3];
            const float s = ((a[0] + a[1]) + (a[2] + a[3])) + ((b[0] + b[1]) + (b[2] + b[3])) + ((c[0] + c[1]) + (c[2] + c[3])) + ((d[0] + d[1]) + (d[2] + d[3]));
            rtab[i * 256 + r] = rsqrtf(s * (1.0f / 1024.0f) + EP_EPS);
        }
    }
    __syncthreads();
}
template <bool ROPE> struct EpiProj {
    static constexpr bool PERM = true, AFTER_DRAIN = false, HAS_INIT = false;
    bf16_t* O; int ldc; const PG8_LAS float* rtab; const float* cosT; const float* sinT;
    __device__ __forceinline__ void operator()(const f32x4 (&acc)[2][2][4][2], const Unit& u, int wr, int wc, int fr, int fq) const {
        const int row0 = u.pm * BM + wr * 64 + fr;
        float rs[2][4]; row_rstd(rtab, u, wr, fr, rs);
        const int col0 = u.pn * BM + wc * 32 + 8 * fq;
        const int i0 = (wc & 1) * 16 + 4 * fq;
        const bool rope = ROPE && (u.pn < 5);
#pragma unroll
        for (int ai = 0; ai < 2; ++ai)
#pragma unroll
            for (int m = 0; m < 4; ++m) {
                const int row = row0 + ai * HALF + m * 16;
                bf16_t* rowp = (bf16_t*)((char*)O + ((unsigned)row * (unsigned)ldc + (unsigned)col0) * 2u);
                const float r = rs[ai][m];
                f32x4 cs = {1.f, 1.f, 1.f, 1.f}, sn = {0.f, 0.f, 0.f, 0.f};
                if (rope) { const unsigned to = ((unsigned)row * 32u + (unsigned)i0) * 4u; cs = *(const f32x4*)((const char*)cosT + to); sn = *(const f32x4*)((const char*)sinT + to); }
#pragma unroll
                for (int bj = 0; bj < 2; ++bj) {
                    f32x4 v0 = acc[ai][bj][m][0] * r, v1 = acc[ai][bj][m][1] * r;
                    if (ROPE) {
                        const f32x4 a = v0, b = v1;
                        v0[0] = a[0] * cs[0] - a[1] * sn[0]; v0[1] = a[1] * cs[0] + a[0] * sn[0];
                        v0[2] = a[2] * cs[1] - a[3] * sn[1]; v0[3] = a[3] * cs[1] + a[2] * sn[1];
                        v1[0] = b[0] * cs[2] - b[1] * sn[2]; v1[1] = b[1] * cs[2] + b[0] * sn[2];
                        v1[2] = b[2] * cs[3] - b[3] * sn[3]; v1[3] = b[3] * cs[3] + b[2] * sn[3];
                    }
                    u32x4 w; w.x = cvt_pk_bf16(v0[0], v0[1]); w.y = cvt_pk_bf16(v0[2], v0[3]); w.z = cvt_pk_bf16(v1[0], v1[1]); w.w = cvt_pk_bf16(v1[2], v1[3]);
                    *(u32x4*)(rowp + bj * HALF) = w;
                }
            }
    }
};
struct EpiSwiGLU {
    static constexpr bool PERM = true, AFTER_DRAIN = false, HAS_INIT = false;
    bf16_t* O; int ldc; const PG8_LAS float* rtab;
    __device__ __forceinline__ void operator()(const f32x4 (&acc)[2][2][4][2], const Unit& u, int wr, int wc, int fr, int fq) const {
        const int row0 = u.pm * BM + wr * 64 + fr;
        float rs[2][4];
        if (rtab) row_rstd(rtab, u, wr, fr, rs); else { for (int a = 0; a < 2; ++a) for (int b = 0; b < 4; ++b) rs[a][b] = 1.0f; }
        const int col0 = u.pn * HALF + wc * 32 + 8 * fq;
#pragma unroll
        for (int ai = 0; ai < 2; ++ai)
#pragma unroll
            for (int m = 0; m < 4; ++m) {
                const int row = row0 + ai * HALF + m * 16;
                const float r = rs[ai][m], c1 = -1.4426950408889634f * r, r2 = r * r;
                unsigned w[4];
#pragma unroll
                for (int n = 0; n < 2; ++n)
#pragma unroll
                    for (int c = 0; c < 2; ++c) {
                        const f32x2 G = {acc[ai][0][m][n][2 * c], acc[ai][0][m][n][2 * c + 1]}, U = {acc[ai][1][m][n][2 * c], acc[ai][1][m][n][2 * c + 1]};
                        const f32x2 t = G * c1;
                        f32x2 e; e.x = __builtin_amdgcn_exp2f(t.x); e.y = __builtin_amdgcn_exp2f(t.y);
                        const f32x2 d = e + 1.0f;
                        f32x2 s; s.x = __builtin_amdgcn_rcpf(d.x); s.y = __builtin_amdgcn_rcpf(d.y);
                        const f32x2 h = ((G * U) * r2) * s;
                        w[n * 2 + c] = cvt_pk_bf16(h.x, h.y);
                    }
                u32x4 wv; wv.x = w[0]; wv.y = w[1]; wv.z = w[2]; wv.w = w[3];
                *(u32x4*)((char*)O + ((unsigned)row * (unsigned)ldc + (unsigned)col0) * 2u) = wv;
            }
    }
};
struct EpiResid {
    static constexpr bool PERM = true, AFTER_DRAIN = false, HAS_INIT = true;
    bf16_t* XB; float* part;
    __device__ __forceinline__ void init_acc(f32x4 (&acc)[2][2][4][2], const Unit& u, int wr, int wc, int fr, int fq) const {
        const int row0 = u.pm * BM + wr * 64 + fr, col0 = u.pn * BM + wc * 32 + 8 * fq;
#pragma unroll
        for (int ai = 0; ai < 2; ++ai)
#pragma unroll
            for (int bj = 0; bj < 2; ++bj)
#pragma unroll
                for (int m = 0; m < 4; ++m) {
                    const int row = row0 + ai * HALF + m * 16;
                    const u32x4 xo = *(const u32x4*)((const char*)XB + ((unsigned)row * 1024u + (unsigned)(col0 + bj * HALF)) * 2u);
                    acc[ai][bj][m][0] = (f32x4){__uint_as_float(xo.x << 16), __uint_as_float(xo.x & 0xffff0000u), __uint_as_float(xo.y << 16), __uint_as_float(xo.y & 0xffff0000u)};
                    acc[ai][bj][m][1] = (f32x4){__uint_as_float(xo.z << 16), __uint_as_float(xo.z & 0xffff0000u), __uint_as_float(xo.w << 16), __uint_as_float(xo.w & 0xffff0000u)};
                }
    }
    __device__ __forceinline__ void operator()(const f32x4 (&acc)[2][2][4][2], const Unit& u, int wr, int wc, int fr, int fq) const {
        const int row0 = u.pm * BM + wr * 64 + fr, col0 = u.pn * BM + wc * 32 + 8 * fq;
#pragma unroll
        for (int ai = 0; ai < 2; ++ai)
#pragma unroll
            for (int m = 0; m < 4; ++m) {
                const int row = row0 + ai * HALF + m * 16;
                float ss = 0.f;
#pragma unroll
                for (int bj = 0; bj < 2; ++bj) {
                    const f32x4 a0 = acc[ai][bj][m][0], a1 = acc[ai][bj][m][1];
                    u32x4 w; w.x = cvt_pk_bf16(a0[0], a0[1]); w.y = cvt_pk_bf16(a0[2], a0[3]); w.z = cvt_pk_bf16(a1[0], a1[1]); w.w = cvt_pk_bf16(a1[2], a1[3]);
                    *(u32x4*)((char*)XB + ((unsigned)row * 1024u + (unsigned)(col0 + bj * HALF)) * 2u) = w;
                    ss += ((a0[0] * a0[0] + a0[1] * a0[1]) + (a0[2] * a0[2] + a0[3] * a0[3])) + ((a1[0] * a1[0] + a1[1] * a1[1]) + (a1[2] * a1[2] + a1[3] * a1[3]));
                }
                ss += shx<16>(ss); ss = xhalf_sum(ss);
                if (fq == 0) *(float*)((char*)part + ((unsigned)row * 64u + (unsigned)(4 * u.pn + wc) * 4u)) = ss;
            }
    }
};
struct EpiNull {
    static constexpr bool PERM = false, AFTER_DRAIN = false, HAS_INIT = false;
    __device__ __forceinline__ void operator()(const f32x4 (&acc)[2][2][4][2], const Unit&, int, int, int, int) const {
#pragma unroll
        for (int ai = 0; ai < 2; ++ai)
#pragma unroll
            for (int bj = 0; bj < 2; ++bj)
#pragma unroll
                for (int m = 0; m < 4; ++m)
#pragma unroll
                    for (int n = 0; n < 2; ++n) asm volatile("" :: "v"(acc[ai][bj][m][n]));
    }
};
template <class Epi, class Sched, bool ALIGN_EPI = false, bool SP2 = false>
__device__ __forceinline__ void gemm_phase(PG8_LAS unsigned char* lds, const Gemm g, const Sched& S, const Epi& E, const int wave_in) {
    int tid_; asm volatile("v_mbcnt_lo_u32_b32 %0, -1, 0\n\tv_mbcnt_hi_u32_b32 %0, -1, %0" : "=v"(tid_)); tid_ += wave_in * 64; asm volatile("" : "+v"(tid_));
    const int tid = tid_, wid = __builtin_amdgcn_readfirstlane(tid >> 6), lane = tid & 63, wr = wid >> 2, wc = wid & 3, fr = lane & 15, fq = lane >> 4;
    const int K = g.K, nt = K / BK;
    unsigned voffA[2], voffB[2];
#pragma unroll
    for (int i = 0; i < 2; ++i) { int R, C; stage_rc(tid * 16 + i * 8192, R, C); const int Rb = Epi::PERM ? ((R & ~31) + perm32(R & 31)) : R;
        voffA[i] = (unsigned)(R * K + C) * 2u; voffB[i] = (unsigned)(Rb * K + C) * 2u; }
    const size_t kstep = (size_t)(BK * 2);
    const size_t hstep = (size_t)HALF * K * 2;
    const size_t tstep = 2 * hstep;
    const unsigned ldsw = (unsigned)wid * 1024u;
    const int aoff = lds_byte(wr * 64 + fr, fq * 8), boff = lds_byte(wc * 32 + fr, fq * 8);
#define PG8_SA(b, h) (((b) * 2 + (h)) * HTB)
#define PG8_SB(b, h) ((4 + (b) * 2 + (h)) * HTB)
#define PG8_STAGE(bufoff, gbase, voff) do { _Pragma("unroll") for (int _i = 0; _i < 2; ++_i) \
        __builtin_amdgcn_global_load_lds((const unsigned*)((const char*)(gbase) + (voff)[_i]), (PG8_LAS unsigned*)(lds + (bufoff) + ldsw + _i * 8192), 16, 0, 0); } while (0)
#define PG8_LDA(dst, b, h) do { _Pragma("unroll") for (int m = 0; m < 4; ++m) _Pragma("unroll") for (int k = 0; k < 2; ++k) dst[m][k] = *(const PG8_LAS bf16x8*)(lds + PG8_SA(b, h) + aoff + m * 2048 + k * 1024); } while (0)
#define PG8_LDB(dst, b, h) do { _Pragma("unroll") for (int n = 0; n < 2; ++n) _Pragma("unroll") for (int k = 0; k < 2; ++k) dst[n][k] = *(const PG8_LAS bf16x8*)(lds + PG8_SB(b, h) + boff + n * 2048 + k * 1024); } while (0)
#define PG8_MMA(ai, bj, At, Bt) do { __builtin_amdgcn_s_setprio(1); _Pragma("unroll") for (int m = 0; m < 4; ++m) _Pragma("unroll") for (int n = 0; n < 2; ++n) _Pragma("unroll") for (int k = 0; k < 2; ++k) \
        acc[ai][bj][m][n] = __builtin_amdgcn_mfma_f32_16x16x32_bf16(Bt[n][k], At[m][k], acc[ai][bj][m][n], 0, 0, 0); __builtin_amdgcn_s_setprio(0); } while (0)
#define PG8_WAIT_V(n) asm volatile("s_waitcnt vmcnt(" #n ")" ::: "memory")
#define PG8_WAIT_L(n) asm volatile("s_waitcnt lgkmcnt(" #n ")" ::: "memory")
#define PG8_BAR __builtin_amdgcn_s_barrier()
#define PG8_SCHED __builtin_amdgcn_sched_barrier(0)
    Unit cur, nxt; int ui = 0;
    if (!S.next(0, cur)) return;
    f32x4 acc[2][2][4][2];
    if constexpr (Epi::HAS_INIT) E.init_acc(acc, cur, wr, wc, fr, fq);
    else {
#pragma unroll
    for (int a = 0; a < 2; ++a)
#pragma unroll
        for (int b = 0; b < 2; ++b)
#pragma unroll
            for (int m = 0; m < 4; ++m)
#pragma unroll
                for (int n = 0; n < 2; ++n) acc[a][b][m][n] = (f32x4){0.f, 0.f, 0.f, 0.f};
    }
    bf16x8 At[4][2], B0[2][2], B1[2][2];
    const char* cA = (const char*)g.A + (size_t)cur.pm * tstep; const char* cB = (const char*)g.Bt + (size_t)cur.pn * tstep;
    S.a_ready(cur);
    if constexpr (SP2) {
        PG8_STAGE(PG8_SB(0, 0), cB, voffB); PG8_STAGE(PG8_SB(0, 1), cB + hstep, voffB); PG8_STAGE(PG8_SA(0, 0), cA, voffA); PG8_STAGE(PG8_SA(0, 1), cA + hstep, voffA);
        if (wr == 1) PG8_BAR;
        PG8_WAIT_V(2); PG8_BAR;
        PG8_STAGE(PG8_SB(1, 0), cB + kstep, voffB); PG8_STAGE(PG8_SA(1, 0), cA + kstep, voffA); PG8_STAGE(PG8_SB(1, 1), cB + hstep + kstep, voffB);
        PG8_WAIT_V(6); PG8_BAR;
    } else {
        PG8_STAGE(PG8_SB(0, 0), cB, voffB); PG8_STAGE(PG8_SA(0, 0), cA, voffA); PG8_STAGE(PG8_SB(0, 1), cB + hstep, voffB); PG8_STAGE(PG8_SA(0, 1), cA + hstep, voffA);
        if (wr == 1) PG8_BAR;
        PG8_WAIT_V(4); PG8_BAR;
        PG8_STAGE(PG8_SB(1, 0), cB + kstep, voffB); PG8_STAGE(PG8_SA(1, 0), cA + kstep, voffA); PG8_STAGE(PG8_SB(1, 1), cB + hstep + kstep, voffB);
        PG8_WAIT_V(6); PG8_BAR;
    }
    for (;;) {
        const bool has_next = S.next(ui + 1, nxt);
        const char* nA = has_next ? (const char*)g.A + (size_t)nxt.pm * tstep : cA; const char* nB = has_next ? (const char*)g.Bt + (size_t)nxt.pn * tstep : cB;
        for (int t = 0; t < nt; t += 2) {
            const bool last = (t == nt - 2);
            const char* a1 = cA + (size_t)(t + 1) * kstep;
            const char* a2 = last ? nA : cA + (size_t)(t + 2) * kstep; const char* b2 = last ? nB : cB + (size_t)(t + 2) * kstep;
            const char* a3 = a2 + kstep; const char* b3 = b2 + kstep;
            if (last && has_next) S.a_ready(nxt);
            if constexpr (SP2) {
            PG8_LDB(B0, 0, 0); PG8_LDB(B1, 0, 1); PG8_SCHED; PG8_LDA(At, 0, 0); PG8_STAGE(PG8_SA(1, 1), a1 + hstep, voffA);
            PG8_WAIT_V(8); PG8_WAIT_L(0); PG8_BAR; PG8_MMA(0, 0, At, B0); PG8_MMA(0, 1, At, B1); PG8_BAR; PG8_SCHED;
            PG8_LDA(At, 0, 1); PG8_STAGE(PG8_SB(0, 0), b2, voffB); PG8_STAGE(PG8_SB(0, 1), b2 + hstep, voffB); PG8_STAGE(PG8_SA(0, 0), a2, voffA);
            PG8_WAIT_V(8); PG8_WAIT_L(0); PG8_BAR; PG8_MMA(1, 0, At, B0); PG8_MMA(1, 1, At, B1); PG8_BAR; PG8_SCHED;
            PG8_LDB(B0, 1, 0); PG8_LDB(B1, 1, 1); PG8_SCHED; PG8_LDA(At, 1, 0); PG8_STAGE(PG8_SA(0, 1), a2 + hstep, voffA);
            PG8_WAIT_V(8); PG8_WAIT_L(0); PG8_BAR; PG8_MMA(0, 0, At, B0); PG8_MMA(0, 1, At, B1); PG8_BAR; PG8_SCHED;
            PG8_LDA(At, 1, 1); PG8_STAGE(PG8_SB(1, 0), b3, voffB); PG8_STAGE(PG8_SB(1, 1), b3 + hstep, voffB); PG8_STAGE(PG8_SA(1, 0), a3, voffA);
            PG8_WAIT_V(8); PG8_WAIT_L(0); PG8_BAR; PG8_MMA(1, 0, At, B0); PG8_MMA(1, 1, At, B1); PG8_BAR; PG8_SCHED;
            } else {
            PG8_LDB(B0, 0, 0); PG8_SCHED; PG8_LDA(At, 0, 0); PG8_STAGE(PG8_SA(1, 1), a1 + hstep, voffA);
            PG8_WAIT_L(8); PG8_BAR; PG8_WAIT_L(0); PG8_MMA(0, 0, At, B0); PG8_BAR; PG8_SCHED;
            PG8_LDB(B1, 0, 1); PG8_STAGE(PG8_SB(0, 0), b2, voffB);
            PG8_BAR; PG8_WAIT_L(0); PG8_MMA(0, 1, At, B1); PG8_BAR;
            PG8_LDA(At, 0, 1); PG8_STAGE(PG8_SA(0, 0), a2, voffA);
            PG8_BAR; PG8_WAIT_L(0); PG8_MMA(1, 0, At, B0); PG8_BAR; PG8_SCHED;
            PG8_STAGE(PG8_SB(0, 1), b2 + hstep, voffB);
            PG8_WAIT_V(6); PG8_BAR; PG8_MMA(1, 1, At, B1); PG8_BAR;
            PG8_LDB(B0, 1, 0); PG8_SCHED; PG8_LDA(At, 1, 0); PG8_STAGE(PG8_SA(0, 1), a2 + hstep, voffA);
            PG8_WAIT_L(8); PG8_BAR; PG8_WAIT_L(0); PG8_MMA(0, 0, At, B0); PG8_BAR; PG8_SCHED;
            PG8_LDB(B1, 1, 1); PG8_STAGE(PG8_SB(1, 0), b3, voffB);
            PG8_BAR; PG8_WAIT_L(0); PG8_MMA(0, 1, At, B1); PG8_BAR;
            PG8_LDA(At, 1, 1); PG8_STAGE(PG8_SA(1, 0), a3, voffA);
            PG8_BAR; PG8_WAIT_L(0); PG8_MMA(1, 0, At, B0); PG8_BAR; PG8_SCHED;
            PG8_STAGE(PG8_SB(1, 1), b3 + hstep, voffB);
            PG8_WAIT_V(6); PG8_BAR; PG8_MMA(1, 1, At, B1); PG8_BAR;
            }
        }
        if constexpr (ALIGN_EPI) { if (wr == 0) PG8_BAR; }
        if constexpr (!Epi::AFTER_DRAIN) { E(acc, cur, wr, wc, fr, fq); S.done(cur); }
        if (!has_next) break;
        if constexpr (Epi::HAS_INIT) E.init_acc(acc, nxt, wr, wc, fr, fq);
        else {
#pragma unroll
        for (int a = 0; a < 2; ++a)
#pragma unroll
            for (int b = 0; b < 2; ++b)
#pragma unroll
                for (int m = 0; m < 4; ++m)
#pragma unroll
                    for (int n = 0; n < 2; ++n) acc[a][b][m][n] = (f32x4){0.f, 0.f, 0.f, 0.f};
        }
        cur = nxt; cA = nA; cB = nB; ++ui;
        if constexpr (ALIGN_EPI) { if (wr == 1) PG8_BAR; }
    }
    PG8_WAIT_V(0);
    if constexpr (!ALIGN_EPI) { if (wr == 0) PG8_BAR; }
    PG8_BAR;
    if constexpr (Epi::AFTER_DRAIN) { E.fused(acc, cur, wr, wc, fr, fq, lds, wid, lane); S.done(cur); }
#undef PG8_SA
#undef PG8_SB
#undef PG8_STAGE
#undef PG8_LDA
#undef PG8_LDB
#undef PG8_MMA
#undef PG8_WAIT_V
#undef PG8_WAIT_L
#undef PG8_BAR
#undef PG8_SCHED
}
}
#define GAS __attribute__((address_space(1)))
#define LAS __attribute__((address_space(3)))
typedef unsigned short bf16;
typedef unsigned v4u __attribute__((ext_vector_type(4)));
typedef float f32x4 __attribute__((ext_vector_type(4)));
typedef short bf16x8 __attribute__((ext_vector_type(8)));
typedef GAS unsigned gu32;
typedef GAS unsigned long long gu64;
#define RLX_AGENT __ATOMIC_RELAXED, __HIP_MEMORY_SCOPE_AGENT
#define LDS_WAIT() asm volatile("s_waitcnt lgkmcnt(0)" ::: "memory")
#define VM_WAIT() asm volatile("s_waitcnt vmcnt(0)" ::: "memory")
__device__ __forceinline__ unsigned long long rt() { return __builtin_amdgcn_s_memrealtime(); }
__device__ __forceinline__ unsigned f2bf(float f) { unsigned u = __builtin_bit_cast(unsigned, f); return (u + 0x7fffu + ((u >> 16) & 1u)) >> 16; }
__device__ __forceinline__ unsigned pk2(float lo, float hi) { return f2bf(lo) | (f2bf(hi) << 16); }

#define XB_TMO      128
#define XB_XCNT(j)  (256  + 64 * (j))
#define XB_XSUB(j)  (1280 + 64 * (j))
#define XB_XGEN(j)  (2304 + 64 * (j))
#define XB_TOP      3328
#define XB_TOPGEN   3392
#define XCD_BAR_WORDS 3456
#define XB_SPIN_CAP (1u << 18)

__device__ __forceinline__ unsigned xb_ld(unsigned* p)              { return __hip_atomic_load(p, __ATOMIC_RELAXED, __HIP_MEMORY_SCOPE_AGENT); }
__device__ __forceinline__ unsigned xb_add(unsigned* p, unsigned v) { return __hip_atomic_fetch_add(p, v, __ATOMIC_RELAXED, __HIP_MEMORY_SCOPE_AGENT); }
__device__ __forceinline__ unsigned xb_xcc_id() { return (unsigned)__builtin_amdgcn_s_getreg((3 << 11) | 20) & 0xFu; }
#define XB_SPIN(cond, bar) do { unsigned _sp = 0; while (cond) { __builtin_amdgcn_s_sleep(1); \
    if ((++_sp & 255u) == 0u) { if (xb_ld(&(bar)[XB_TMO])) break; if (_sp > XB_SPIN_CAP) { atomicAdd(&(bar)[XB_TMO], 1u); break; } } } } while (0)

struct XcdBarrier {
    unsigned* bar; unsigned x;
    volatile LAS unsigned* st;
};

__device__ __forceinline__ XcdBarrier xcd_barrier_post(unsigned* bar, volatile LAS unsigned* st) {
    XcdBarrier b; b.bar = bar; b.x = xb_xcc_id(); b.st = st;
    if (threadIdx.x == 0) (void)xb_add(&bar[XB_XCNT(b.x)], 1u);
    return b;
}
__device__ __forceinline__ void xcd_barrier_complete(unsigned* bar, unsigned x, unsigned& nloc, unsigned& nx) {
    const unsigned G = gridDim.x * gridDim.y * gridDim.z;
    unsigned sum, cnt, mine, sp = 0u;
    for (;;) {
        sum = 0u; cnt = 0u; mine = 0u;
#pragma unroll
        for (unsigned j = 0; j < 16; ++j) { const unsigned c = xb_ld(&bar[XB_XCNT(j)]); sum += c; cnt += (c > 0u) ? 1u : 0u; mine = (j == x) ? c : mine; }
        if (sum == G) break;
        __builtin_amdgcn_s_sleep(1);
        if ((++sp & 255u) == 0u) { if (xb_ld(&bar[XB_TMO])) break; if (sp > XB_SPIN_CAP) { atomicAdd(&bar[XB_TMO], 1u); break; } }
    }
    nloc = mine > 0u ? mine : 1u; nx = cnt > 0u ? cnt : 1u;
}

__device__ __forceinline__ void xcd_barrier(const XcdBarrier& b) {
    asm volatile("s_waitcnt vmcnt(0)" ::: "memory");
    __syncthreads();
    if (threadIdx.x == 0) {
        unsigned* bar = b.bar;
        __builtin_amdgcn_s_waitcnt(0);
        unsigned nloc = b.st[0], nx = b.st[1];
        if (nloc == 0u) { xcd_barrier_complete(bar, b.x, nloc, nx); b.st[0] = nloc; b.st[1] = nx; }
        const unsigned old = xb_add(&bar[XB_XSUB(b.x)], 1u);
        const unsigned gen = old / nloc;
        if (old + 1u == (gen + 1u) * nloc) {
            __builtin_amdgcn_fence(__ATOMIC_RELEASE, "agent");
            asm volatile("s_waitcnt vmcnt(0)" ::: "memory");
            const unsigned og = xb_add(&bar[XB_TOP], 1u);
            const unsigned tg = og / nx;
            if (og + 1u == (tg + 1u) * nx) xb_add(&bar[XB_TOPGEN], 1u);
            else XB_SPIN(xb_ld(&bar[XB_TOPGEN]) == tg, bar);
            __builtin_amdgcn_fence(__ATOMIC_ACQUIRE, "agent");
            xb_add(&bar[XB_XGEN(b.x)], 1u);
            asm volatile("s_waitcnt vmcnt(0)" ::: "memory");
        } else {
            XB_SPIN(xb_ld(&bar[XB_XGEN(b.x)]) == gen, bar);
            __builtin_amdgcn_fence(__ATOMIC_ACQUIRE, "agent");
            asm volatile("s_waitcnt vmcnt(0)" ::: "memory");
        }
    }
    __syncthreads();
}


constexpr int NWAVES = 8;
constexpr int M = 16384, SEQ = 8192, D = 1024, DFF = 2816, MW = 3088, MP = 3072, AW = 1536;
constexpr float EPS = 1e-6f;
constexpr size_t MiB = 1u << 20;
constexpr size_t WS_CTL = 0, CTL_ZERO_BYTES = 1 * MiB;
constexpr size_t WS_PART = 1 * MiB;
constexpr size_t WS_GATES = 2 * MiB;
constexpr size_t WS_SMALL = 3 * MiB;
constexpr size_t WS_ROPE = 4 * MiB;
constexpr size_t WS_NBUF = 8 * MiB;
constexpr size_t WS_WG = 9 * MiB;
constexpr size_t WS_W = 10 * MiB;
constexpr size_t W_MIN = WS_W, W_MOUT = W_MIN + 12 * MiB, W_AIN = W_MOUT + 4 * MiB, W_AOUT = W_AIN + 6 * MiB, W_FIN = W_AOUT + 4 * MiB, W_FOUT = W_FIN + 44 * MiB;
constexpr size_t WS_XB = 102 * MiB;
constexpr size_t WS_HS = 134 * MiB;
constexpr size_t WS_PROJ = 166 * MiB;
constexpr size_t WS_KV = 262 * MiB;
constexpr size_t WS_END = 326 * MiB;
static_assert(W_FOUT + 22 * MiB == WS_XB, "weight map");
constexpr int CW_BAR = 4096;

constexpr int RING_OFF = 0, RING_BYTES = 131072;
constexpr int LDSCTL_OFF = RING_BYTES, MISC_OFF = LDSCTL_OFF + 320;
constexpr int LDS_BYTES = 147456;

using pg8::shx; using pg8::xhalf_sum; using pg8::xhalf_max;
__device__ __forceinline__ float wave_sum(float v) { v += shx<1>(v); v += shx<2>(v); v += shx<4>(v); v += shx<8>(v); v += shx<16>(v); return xhalf_sum(v); }
__device__ __forceinline__ float wave_max(float v) { v = fmaxf(v, shx<1>(v)); v = fmaxf(v, shx<2>(v)); v = fmaxf(v, shx<4>(v)); v = fmaxf(v, shx<8>(v)); v = fmaxf(v, shx<16>(v)); return xhalf_max(v); }
#define DPPF(old, src, ctrl, rm) __int_as_float(__builtin_amdgcn_update_dpp(__float_as_int(old), __float_as_int(src), ctrl, rm, 0xf, false))
__device__ __forceinline__ float wscan_add(float v) {
    v += DPPF(0.f, v, 0x111, 0xf); v += DPPF(0.f, v, 0x112, 0xf); v += DPPF(0.f, v, 0x114, 0xf); v += DPPF(0.f, v, 0x118, 0xf); v += DPPF(0.f, v, 0x142, 0xa); v += DPPF(0.f, v, 0x143, 0xc); return v; }
__device__ __forceinline__ float wscan_max(float v) {
    const float ni = -INFINITY;
    v = fmaxf(v, DPPF(ni, v, 0x111, 0xf)); v = fmaxf(v, DPPF(ni, v, 0x112, 0xf)); v = fmaxf(v, DPPF(ni, v, 0x114, 0xf)); v = fmaxf(v, DPPF(ni, v, 0x118, 0xf)); v = fmaxf(v, DPPF(ni, v, 0x142, 0xa)); v = fmaxf(v, DPPF(ni, v, 0x143, 0xc)); return v; }
__device__ __forceinline__ float wave_shr1(float v, float fill) { return DPPF(fill, v, 0x138, 0xf); }
__device__ __forceinline__ float lane63(float v) { return __int_as_float(__builtin_amdgcn_readlane(__float_as_int(v), 63)); }
__device__ __forceinline__ float bf2f(unsigned short b) { return __uint_as_float((unsigned)b << 16); }
__device__ __forceinline__ float log_sigmoidf(float x) { return fminf(x, 0.f) - __logf(1.0f + __expf(-fabsf(x))); }

struct Args { const float* in[14]; float* out; unsigned char* ws; int ph_lo, ph_hi, dup, pad; };

struct ColMap {
    int type;
    __device__ __forceinline__ int dst(int s) const {
        if (type == 2) { if (s >= 1280) return s; const int p = s & 63; return (s & ~63) + (p < 32 ? 2 * p : 2 * (p - 32) + 1); }
        if (type == 3) { return s < DFF ? 256 * (s >> 7) + (s & 127) : 256 * ((s - DFF) >> 7) + 128 + ((s - DFF) & 127); }
        return s;
    }
    __device__ __forceinline__ float scale(int s) const {
        if (type == 1) return s < 512 ? 0.08838834764831845f : 1.0f;
        if (type == 2) return s < 1024 ? 0.18033688011112042f : 1.0f;
        return 1.0f;
    }
};
__device__ __forceinline__ void wt_item(const float* W, int ldn, int K, const float* nw, bf16* WT, ColMap mp, LAS float* scr, int item, int nblk, int lane) {
    const int kb = item / nblk, nb = item % nblk, k0 = 64 * kb, s0 = 32 * nb;
    const int ks = lane >> 3, c4 = lane & 7;
    f32x4 v[8];
#pragma unroll
    for (int i = 0; i < 8; ++i) v[i] = *(const GAS f32x4*)(W + (size_t)(k0 + 8 * i + ks) * ldn + s0 + 4 * c4);
    const float sc = mp.scale(s0 + 4 * c4);
#pragma unroll
    for (int i = 0; i < 8; ++i) { const float w = nw ? nw[k0 + 8 * i + ks] * sc : sc; LAS float* d = scr + (8 * i + ks) * 33 + 4 * c4;
        d[0] = v[i].x * w; d[1] = v[i].y * w; d[2] = v[i].z * w; d[3] = v[i].w * w; }
    LDS_WAIT(); asm volatile("" ::: "memory");
    const int c = lane & 7;
#pragma unroll
    for (int j = 0; j < 4; ++j) { const int n = (lane >> 3) + 8 * j; const LAS float* sp = scr + (8 * c) * 33 + n;
        v4u o; o.x = pk2(sp[0 * 33], sp[1 * 33]); o.y = pk2(sp[2 * 33], sp[3 * 33]); o.z = pk2(sp[4 * 33], sp[5 * 33]); o.w = pk2(sp[6 * 33], sp[7 * 33]);
        *(GAS v4u*)(WT + (size_t)mp.dst(s0 + n) * K + k0 + 8 * c) = o; }
    LDS_WAIT(); asm volatile("" ::: "memory");
}

struct Ptrs {
    const float *x; const int* pos; const float *norm_mix_w, *norm_ffn_w, *norm_final_w, *mlstm_w_in, *mlstm_b_gate, *mlstm_norm_w, *mlstm_w_out, *attn_w_in, *attn_sink, *attn_w_out, *ffn_w_in, *ffn_w_out;
    float* out; unsigned char* ws;
};

__device__ __forceinline__ void p0_prologue(const Ptrs& P, LAS unsigned char* lds, int vcu, int G, int wave, int lane) {
    LAS float* scr = (LAS float*)(lds + RING_OFF + wave * 16384);
    const int gw = vcu * NWAVES + wave, NGW = G * NWAVES;
    constexpr int I_MIN = 16 * 96, I_SQ = 16 * 32, I_AIN = 16 * 48, I_FIN = 16 * 176, I_FOUT = 44 * 32;
    constexpr int NITEMS = 2 * I_MIN + 2 * I_SQ + 2 * I_AIN + 2 * I_SQ + 4 * I_FIN + 4 * I_FOUT;
    unsigned char* ws = P.ws;
    for (int it = gw; it < NITEMS; it += NGW) {
        int r = it;
        if (r < 2 * I_MIN) { const int L = r / I_MIN; r %= I_MIN; wt_item(P.mlstm_w_in + (size_t)L * D * MW, MW, D, P.norm_mix_w + (2 * L) * D, (bf16*)(ws + W_MIN) + (size_t)L * MP * D, ColMap{1}, scr, r, MP / 32, lane); continue; } r -= 2 * I_MIN;
        if (r < 2 * I_SQ) { const int L = r / I_SQ; r %= I_SQ; wt_item(P.mlstm_w_out + (size_t)L * D * D, D, D, nullptr, (bf16*)(ws + W_MOUT) + (size_t)L * D * D, ColMap{0}, scr, r, D / 32, lane); continue; } r -= 2 * I_SQ;
        if (r < 2 * I_AIN) { const int L = r / I_AIN; r %= I_AIN; wt_item(P.attn_w_in + (size_t)L * D * AW, AW, D, P.norm_mix_w + (2 * L + 1) * D, (bf16*)(ws + W_AIN) + (size_t)L * AW * D, ColMap{2}, scr, r, AW / 32, lane); continue; } r -= 2 * I_AIN;
        if (r < 2 * I_SQ) { const int L = r / I_SQ; r %= I_SQ; wt_item(P.attn_w_out + (size_t)L * D * D, D, D, nullptr, (bf16*)(ws + W_AOUT) + (size_t)L * D * D, ColMap{0}, scr, r, D / 32, lane); continue; } r -= 2 * I_SQ;
        if (r < 4 * I_FIN) { const int L = r / I_FIN; r %= I_FIN; wt_item(P.ffn_w_in + (size_t)L * D * 2 * DFF, 2 * DFF, D, P.norm_ffn_w + L * D, (bf16*)(ws + W_FIN) + (size_t)L * 2 * DFF * D, ColMap{3}, scr, r, 2 * DFF / 32, lane); continue; } r -= 4 * I_FIN;
        { const int L = r / I_FOUT; r %= I_FOUT; wt_item(P.ffn_w_out + (size_t)L * DFF * D, D, DFF, nullptr, (bf16*)(ws + W_FOUT) + (size_t)L * D * DFF, ColMap{0}, scr, r, D / 32, lane); }
    }
    float* part = (float*)(ws + WS_PART); bf16* xb = (bf16*)(ws + WS_XB);
    for (int m = gw; m < M; m += NGW) {
        const GAS f32x4* xr = (const GAS f32x4*)(P.x + (size_t)m * D) + lane;
        GAS unsigned long long* o8 = (GAS unsigned long long*)(xb + (size_t)m * D) + lane;
        float s = 0.f;
#pragma unroll
        for (int j = 0; j < 4; ++j) { const f32x4 v = xr[64 * j]; s += (v.x * v.x + v.y * v.y) + (v.z * v.z + v.w * v.w);
            o8[64 * j] = (unsigned long long)pk2(v.x, v.y) | ((unsigned long long)pk2(v.z, v.w) << 32); }
        s = wave_sum(s);
        if (lane < 16) part[(size_t)m * 16 + lane] = lane == 0 ? s : 0.f;
    }
    float* cosT = (float*)(ws + WS_ROPE); float* sinT = cosT + (size_t)M * 32;
    for (int idx = gw * 64 + lane; idx < M * 32; idx += NGW * 64) {
        const int t = idx >> 5, i = idx & 31;
        const float inv = powf(10000.0f, -(float)i / 32.0f);
        const float ang = (float)P.pos[t] * inv;
        cosT[idx] = cosf(ang); sinT[idx] = sinf(ang);
    }
    bf16* wg = (bf16*)(ws + WS_WG);
    for (int idx = gw * 64 + lane; idx < 2 * 16 * 1024; idx += NGW * 64) {
        const int L = idx >> 14, g = (idx >> 10) & 15, k = idx & 1023;
        wg[idx] = (bf16)f2bf(P.mlstm_w_in[(size_t)L * D * MW + (size_t)k * MW + 3072 + g] * P.norm_mix_w[(2 * L) * D + k]);
    }
}

typedef float f32x4v __attribute__((ext_vector_type(4)));
__device__ __forceinline__ void gates_step(const Ptrs& P, int L, LAS unsigned char* lds, int blk, int wave, int lane) {
    unsigned char* ws = P.ws;
    const bf16* xb = (const bf16*)(ws + WS_XB); const bf16* wg = (const bf16*)(ws + WS_WG) + (size_t)L * 16 * 1024;
    const float* part = (const float*)(ws + WS_PART); float* gates = (float*)(ws + WS_GATES);
    const int tg = wave & 3, kh = wave >> 2, fr = lane & 15, fq = lane >> 4;
    const int row0 = blk * 64 + tg * 16;
    f32x4v acc = {0.f, 0.f, 0.f, 0.f};
    const bf16* ap = xb + (size_t)(row0 + fr) * D + kh * 512 + fq * 8;
    const bf16* bp = wg + (size_t)fr * 1024 + kh * 512 + fq * 8;
    bf16x8 av[16], bv[16];
#pragma unroll
    for (int s = 0; s < 16; ++s) { av[s] = *(const bf16x8*)(ap + s * 32); bv[s] = *(const bf16x8*)(bp + s * 32); }
#pragma unroll
    for (int s = 0; s < 16; ++s) acc = __builtin_amdgcn_mfma_f32_16x16x32_bf16(av[s], bv[s], acc, 0, 0, 0);
    LAS f32x4v* ex = (LAS f32x4v*)(lds + RING_OFF);
    if (kh == 1) ex[tg * 64 + lane] = acc;
    __syncthreads();
    if (kh == 0) {
        const f32x4v o = ex[tg * 64 + lane]; acc = acc + o;
        const int g = fr; const float bias = P.mlstm_b_gate[L * 16 + g];
#pragma unroll
        for (int r = 0; r < 4; ++r) {
            const int row = row0 + 4 * fq + r;
            float s = 0.f;
#pragma unroll
            for (int p = 0; p < 4; ++p) { const f32x4 pv = *(const f32x4*)(part + (size_t)row * 16 + 4 * p); s += (pv.x + pv.y) + (pv.z + pv.w); }
            const float rstd = rsqrtf(s * (1.0f / 1024.0f) + EPS);
            float v = acc[r] * rstd + bias;
            if (g & 4) v = log_sigmoidf(v);
            gates[(size_t)row * 16 + g] = v;
        }
    }
    __syncthreads();
}

typedef float f32x16 __attribute__((ext_vector_type(16)));
typedef short s16x4 __attribute__((ext_vector_type(4)));
typedef unsigned v2u __attribute__((ext_vector_type(2)));
constexpr int XTRA_OFF = LDSCTL_OFF + 1024;
static_assert(XTRA_OFF + 15 * 1024 <= LDS_BYTES, "LDS map");

__device__ __forceinline__ int crow(int r, int hh) { return (r & 3) + 8 * (r >> 2) + 4 * hh; }
__device__ __forceinline__ s16x4 tr_read(LAS const unsigned char* p) { return __builtin_bit_cast(s16x4, __builtin_amdgcn_ds_read_tr16_b64_v4i16((LAS s16x4*)p)); }
__device__ __forceinline__ bf16x8 cat8(s16x4 lo, s16x4 hi) { return (bf16x8){lo[0], lo[1], lo[2], lo[3], hi[0], hi[1], hi[2], hi[3]}; }
typedef float cv_f32x2 __attribute__((ext_vector_type(2))); typedef __bf16 cv_bf16x2 __attribute__((ext_vector_type(2)));
__device__ __forceinline__ unsigned cvtpk(float lo, float hi) { const cv_f32x2 v = {lo, hi}; const cv_bf16x2 b = __builtin_convertvector(v, cv_bf16x2); return __builtin_bit_cast(unsigned, b); }

constexpr int AT_ROWS = 320, AT_K = 0, AT_V = AT_ROWS * 128, AT_OST = 2 * AT_ROWS * 128, AT_OSTRIDE = 144;
static_assert(AT_OST + 8 * 32 * AT_OSTRIDE <= RING_BYTES, "attention LDS map");
template <bool EDGE> __device__ __forceinline__ void attn_item(LAS unsigned char* lds, const bf16x8 (&qf)[4], float m0, int q0, int rb, int lane, f32x16 (&oT)[2], float& l_out) {
    const int r32 = lane & 31, hh = lane >> 5;
    const int qpos = q0 + 32 * rb + r32;
#define AT_QK(xv, kb_) do { const int kr_ = 32 * rb + 32 * (kb_) + r32; LAS const unsigned char* kbp_ = lds + AT_K + kr_ * 128; const int sw_ = (kr_ >> 1) & 7; xv = (f32x16){}; \
        _Pragma("unroll") for (int s = 0; s < 4; ++s) { const bf16x8 kf_ = *(LAS const bf16x8*)(kbp_ + (((2 * s + hh) ^ sw_) << 4)); xv = __builtin_amdgcn_mfma_f32_32x32x16_bf16(kf_, qf[s], xv, 0, 0, 0); } } while (0)
    float m = m0, l = (hh == 0) ? 1.0f : 0.0f;
    oT[0] = (f32x16){}; oT[1] = (f32x16){};
#define AT_STEP(xcu, xnx, kb_, MASK, HASNEXT) do { \
        if (HASNEXT) AT_QK(xnx, (kb_) + 1); \
        if ((MASK) || EDGE) { _Pragma("unroll") for (int r = 0; r < 16; ++r) { const int kp = q0 - 128 + 32 * rb + 32 * (kb_) + crow(r, hh); const int dd = qpos - kp; \
                const bool ok = (kp >= 0) && (kp < SEQ) && (dd <= 128) && (dd >= -128); xcu[r] = ok ? xcu[r] : -INFINITY; } } \
        float bm = fmaxf(fmaxf(fmaxf(fmaxf(xcu[0], xcu[1]), fmaxf(xcu[2], xcu[3])), fmaxf(fmaxf(xcu[4], xcu[5]), fmaxf(xcu[6], xcu[7]))), fmaxf(fmaxf(fmaxf(xcu[8], xcu[9]), fmaxf(xcu[10], xcu[11])), fmaxf(fmaxf(xcu[12], xcu[13]), fmaxf(xcu[14], xcu[15])))); \
        bm = xhalf_max(bm); \
        const float mn = fmaxf(m, bm), f = __builtin_amdgcn_exp2f(m - mn); \
        m = mn; \
        _Pragma("unroll") for (int r = 0; r < 16; ++r) { oT[0][r] *= f; oT[1][r] *= f; } \
        float ps = 0.f; \
        _Pragma("unroll") for (int r = 0; r < 16; ++r) { xcu[r] = __builtin_amdgcn_exp2f(xcu[r] - m); ps += xcu[r]; } \
        l = l * f + ps; \
        bf16x8 pb[2]; \
        _Pragma("unroll") for (int s = 0; s < 2; ++s) { v4u w; w.x = cvtpk(xcu[8 * s + 0], xcu[8 * s + 1]); w.y = cvtpk(xcu[8 * s + 2], xcu[8 * s + 3]); w.z = cvtpk(xcu[8 * s + 4], xcu[8 * s + 5]); w.w = cvtpk(xcu[8 * s + 6], xcu[8 * s + 7]); pb[s] = __builtin_bit_cast(bf16x8, w); } \
        _Pragma("unroll") for (int s = 0; s < 2; ++s) _Pragma("unroll") for (int eb = 0; eb < 2; ++eb) { \
                const int R0 = 32 * rb + 32 * (kb_) + 16 * s + 4 * hh + ((lane & 15) >> 2), ch = 4 * eb + 2 * ((lane >> 4) & 1) + ((lane & 3) >> 1); \
                const s16x4 lo = tr_read(lds + AT_V + R0 * 128 + ((ch ^ (((R0 >> 1) & 1) << 2)) << 4) + 8 * (lane & 1)); \
                const s16x4 hi = tr_read(lds + AT_V + (R0 + 8) * 128 + ((ch ^ ((((R0 + 8) >> 1) & 1) << 2)) << 4) + 8 * (lane & 1)); \
                oT[eb] = __builtin_amdgcn_mfma_f32_32x32x16_bf16(cat8(lo, hi), pb[s], oT[eb], 0, 0, 0); }     \
        __builtin_amdgcn_sched_barrier(0); \
    } while (0)
    f32x16 xa, xb; AT_QK(xa, 0);
    AT_STEP(xa, xb, 0, true, true);
#pragma unroll 1
    for (int kb = 1; kb < 7; kb += 2) { AT_STEP(xb, xa, kb, false, true); AT_STEP(xa, xb, kb + 1, false, true); }
    AT_STEP(xb, xa, 7, false, true);
    AT_STEP(xa, xb, 8, true, false);
#undef AT_STEP
#undef AT_QK
    l_out = xhalf_sum(l);
}
__device__ __forceinline__ void attn_phase(const bf16* proj, const float* sink, bf16* hs, LAS unsigned char* lds, int vcu, int G, int tid, const int dry = 0) {
    const int wave = __builtin_amdgcn_readfirstlane(tid >> 6), g = wave & 3, rb = wave >> 2;
    LAS unsigned char* ost = lds + AT_OST + wave * (32 * AT_OSTRIDE);
    v4u kreg[5], vreg[5];
#define AT_LOAD(item_) do { const int b_ = (item_) >> 9, hkv_ = ((item_) >> 7) & 3, q0_ = ((item_) & 127) * 64; \
        _Pragma("unroll") for (int i = 0; i < 5; ++i) { const int idx = tid_i + 512 * i, row = idx >> 3, c = idx & 7, kp = q0_ - 128 + row; \
            kreg[i] = (v4u){0u, 0u, 0u, 0u}; vreg[i] = (v4u){0u, 0u, 0u, 0u}; \
            if (kp >= 0 && kp < SEQ) { const bf16* src = proj + (size_t)(b_ * SEQ + kp) * AW + 1024 + hkv_ * 64 + c * 8; kreg[i] = *(const v4u*)src; vreg[i] = *(const v4u*)(src + 256); } } \
        } while (0)
    { int tid_i = tid; if (vcu < 1024) AT_LOAD(vcu); }
    for (int item = vcu; item < 1024; item += G) {
        int tid_i = tid; asm volatile("" : "+v"(tid_i));
        const int lane = tid_i & 63, r32 = lane & 31, hh = lane >> 5;
        const int b = item >> 9, hkv = (item >> 7) & 3, qb = item & 127, q0 = qb * 64, hq = hkv * 4 + g;
        bf16x8 qf[4];
        { const bf16* qp = proj + (size_t)(b * SEQ + q0 + 32 * rb + r32) * AW + hq * 64 + 8 * hh;
#pragma unroll
          for (int s = 0; s < 4; ++s) qf[s] = *(const bf16x8*)(qp + 16 * s); }
#pragma unroll
        for (int i = 0; i < 5; ++i) {
            const int idx = tid_i + 512 * i, row = idx >> 3, c = idx & 7;
            *(LAS v4u*)(lds + AT_K + row * 128 + ((c ^ ((row >> 1) & 7)) << 4)) = kreg[i];
            *(LAS v4u*)(lds + AT_V + row * 128 + ((c ^ (((row >> 1) & 1) << 2)) << 4)) = vreg[i];
        }
        const float m0 = sink[hq] * 1.4426950408889634f;
        __syncthreads();
        if (item + G < 1024) AT_LOAD(item + G);
        if (dry == 1) { asm volatile("" :: "v"(qf[0]), "v"(qf[1]), "v"(qf[2]), "v"(qf[3])); __syncthreads(); continue; }
        f32x16 oT[2]; float l;
        if ((q0 < 128) || (q0 + 192 > SEQ)) attn_item<true>(lds, qf, m0, q0, rb, lane, oT, l); else attn_item<false>(lds, qf, m0, q0, rb, lane, oT, l);
        if (dry >= 2) { asm volatile("" :: "v"(oT[0]), "v"(oT[1]), "v"(l)); __syncthreads(); continue; }
        const float rl = 1.0f / l;
#pragma unroll
        for (int eb = 0; eb < 2; ++eb)
#pragma unroll
            for (int k4 = 0; k4 < 4; ++k4) { v2u w; w.x = cvtpk(oT[eb][4 * k4 + 0] * rl, oT[eb][4 * k4 + 1] * rl); w.y = cvtpk(oT[eb][4 * k4 + 2] * rl, oT[eb][4 * k4 + 3] * rl);
                *(LAS v2u*)(ost + r32 * AT_OSTRIDE + (32 * eb + 8 * k4 + 4 * hh) * 2) = w; }
        LDS_WAIT();
        { bf16* op = hs + (size_t)(b * SEQ + q0 + 32 * rb) * D + hq * 64;
#pragma unroll
          for (int i = 0; i < 4; ++i) { const int row = i * 8 + (lane >> 3), chn = lane & 7; const v4u v = *(LAS const v4u*)(ost + row * AT_OSTRIDE + chn * 16); *(v4u*)(op + (size_t)row * D + chn * 8) = v; } }
        __syncthreads();
    }
#undef AT_LOAD
}

__device__ __forceinline__ int qk8(int row, int g8) { return row * 256 + ((g8 ^ (row & 31)) << 3); }
__device__ __forceinline__ int vt16(int row, int c16, int rowbytes) { return row * rowbytes + ((c16 ^ ((row & 3) << 2)) << 4); }
__device__ __forceinline__ void unpack8(v4u w, float (&f)[8]) {
    f[0] = __uint_as_float(w.x << 16); f[1] = __uint_as_float(w.x & 0xffff0000u); f[2] = __uint_as_float(w.y << 16); f[3] = __uint_as_float(w.y & 0xffff0000u);
    f[4] = __uint_as_float(w.z << 16); f[5] = __uint_as_float(w.z & 0xffff0000u); f[6] = __uint_as_float(w.w << 16); f[7] = __uint_as_float(w.w & 0xffff0000u);
}
constexpr int ML_A = 0, ML_B = 32768, ML_V = 65536;

__device__ __forceinline__ void mlstm_chunk_phase(const bf16* proj, const float* gates, bf16* kvb, float* nbuf, float* blam, LAS unsigned char* lds, int vcu, int G, int tid) {
    const int wave = __builtin_amdgcn_readfirstlane(tid >> 6), db = wave & 3, eh = wave >> 2;
    LAS float* gs = (LAS float*)(lds + XTRA_OFF);
    LAS float* wv = gs + 512;
    for (int item = vcu; item < 512; item += G) {
        int tid_i = tid; asm volatile("" : "+v"(tid_i));
        const int tid = tid_i, lane = tid & 63, hh = lane >> 5;
        const int bh = item >> 6, c = item & 63, b = bh >> 2, h = bh & 3, tok0 = b * SEQ + c * 128;
        { const int s = tid & 127, which = tid >> 7; gs[which * 128 + s] = gates[(size_t)(tok0 + s) * 16 + which * 4 + h]; }
#pragma unroll
        for (int i = 0; i < 8; ++i) { const int idx = tid + 512 * i, row = idx >> 5, c16 = idx & 31;
            const v4u v = *(const v4u*)(proj + (size_t)(tok0 + row) * MP + 1024 + h * 256 + c16 * 8);
            *(LAS v4u*)(lds + ML_V + vt16(row, c16, 512)) = v; }
        __syncthreads();
        if (wave < 2) {
            const int dir = wave, s0 = dir ? 127 - 2 * lane : 2 * lane, s1 = dir ? 126 - 2 * lane : 2 * lane + 1;
            const float li0 = gs[dir * 256 + s0], lf0 = gs[dir * 256 + 128 + s0], li1 = gs[dir * 256 + s1], lf1 = gs[dir * 256 + 128 + s1];
            const float pair = lf0 + lf1, inc = wscan_add(pair), exc = inc - pair, b0 = exc + lf0, b1 = inc;
            const float bl = lane63(inc);
            const float a0 = bl - b0 + li0, a1 = bl - b1 + li1;
            const float am = wave_max(fmaxf(a0, a1));
            wv[dir * 128 + s0] = __expf(a0 - am); wv[dir * 128 + s1] = __expf(a1 - am);
            if (lane == 0) { blam[((size_t)(dir * 8 + bh) * 64 + c) * 2] = bl; blam[((size_t)(dir * 8 + bh) * 64 + c) * 2 + 1] = am; }
        }
        __syncthreads();
#pragma unroll
        for (int i = 0; i < 4; ++i) { const int idx = tid + 512 * i, row = idx >> 4, c16 = idx & 15;
            const v4u kv = *(const v4u*)(proj + (size_t)(tok0 + row) * MP + 512 + h * 128 + c16 * 8);
            float f[8]; unpack8(kv, f);
            const float w0 = wv[row], w1 = wv[128 + row];
            v4u a, bb;
            a.x = cvtpk(f[0] * w0, f[1] * w0); a.y = cvtpk(f[2] * w0, f[3] * w0); a.z = cvtpk(f[4] * w0, f[5] * w0); a.w = cvtpk(f[6] * w0, f[7] * w0);
            bb.x = cvtpk(f[0] * w1, f[1] * w1); bb.y = cvtpk(f[2] * w1, f[3] * w1); bb.z = cvtpk(f[4] * w1, f[5] * w1); bb.w = cvtpk(f[6] * w1, f[7] * w1);
            *(LAS v4u*)(lds + ML_A + vt16(row, c16, 256)) = a; *(LAS v4u*)(lds + ML_B + vt16(row, c16, 256)) = bb; }
        __syncthreads();
        if (tid < 256) {
            const int dir = tid >> 7, d = tid & 127; float s = 0.f;
            LAS const unsigned char* kb = lds + (dir ? ML_B : ML_A);
#pragma unroll 8
            for (int r = 0; r < 128; ++r) s += bf2f(*(LAS const unsigned short*)(kb + vt16(r, d >> 3, 256) + (d & 7) * 2));
            nbuf[((size_t)(dir * 8 + bh) * 64 + c) * 128 + d] = s;
        }
        f32x16 af[4], ab[4];
#pragma unroll
        for (int e = 0; e < 4; ++e) { af[e] = (f32x16){}; ab[e] = (f32x16){}; }
        const int q4 = (lane & 15) >> 2, lo8 = 8 * (lane & 1), cq = 2 * ((lane >> 4) & 1) + ((lane & 3) >> 1);
#pragma unroll 2
        for (int ks = 0; ks < 8; ++ks) {
            const int R = 16 * ks + 8 * hh + q4;
            const int cha = 4 * db + cq;
            const bf16x8 Af = cat8(tr_read(lds + ML_A + vt16(R, cha, 256) + lo8), tr_read(lds + ML_A + vt16(R + 4, cha, 256) + lo8));
            const bf16x8 Ab = cat8(tr_read(lds + ML_B + vt16(R, cha, 256) + lo8), tr_read(lds + ML_B + vt16(R + 4, cha, 256) + lo8));
#pragma unroll
            for (int eb = 0; eb < 4; ++eb) {
                const int chv = 4 * (4 * eh + eb) + cq;
                const bf16x8 Bv = cat8(tr_read(lds + ML_V + vt16(R, chv, 512) + lo8), tr_read(lds + ML_V + vt16(R + 4, chv, 512) + lo8));
                af[eb] = __builtin_amdgcn_mfma_f32_32x32x16_bf16(Af, Bv, af[eb], 0, 0, 0);
                ab[eb] = __builtin_amdgcn_mfma_f32_32x32x16_bf16(Ab, Bv, ab[eb], 0, 0, 0);
            }
        }
#pragma unroll
        for (int dir = 0; dir < 2; ++dir) {
            char* ob = (char*)(kvb + ((size_t)(dir * 8 + bh) * 64 + c) * 32768 + (size_t)(db * 8 + 4 * eh) * 1024);
            const unsigned olo = (unsigned)lane * 16u;
#pragma unroll
            for (int eb = 0; eb < 4; ++eb)
#pragma unroll
                for (int k2 = 0; k2 < 2; ++k2) {
                    const f32x16& a = dir ? ab[eb] : af[eb];
                    v4u w; w.x = cvtpk(a[8 * k2 + 0], a[8 * k2 + 1]); w.y = cvtpk(a[8 * k2 + 2], a[8 * k2 + 3]); w.z = cvtpk(a[8 * k2 + 4], a[8 * k2 + 5]); w.w = cvtpk(a[8 * k2 + 6], a[8 * k2 + 7]);
                    *(v4u*)(ob + (unsigned)((eb * 2 + k2) * 1024) + olo) = w;
                }
        }
        __syncthreads();
    }
}

__device__ __forceinline__ void mlstm_scan_phase(bf16* kvb, float* nbuf, const float* blam, float* mprev, int bx, int G, int tid, const int dry = 0) {
    for (int u = bx; u < 256; u += G) {
        const int seq = u >> 4, slab = u & 15, dir = seq >> 3;
        bf16* base = kvb + (size_t)seq * 64 * 32768 + (size_t)(slab * 512 + tid) * 4;
        const bool do_n = (slab == 0) && (tid < 128);
        float st[4] = {0.f, 0.f, 0.f, 0.f}, nst = 0.f, m = 0.f;
        for (int cc = 0; cc < 64; cc += 8) {
            v2u ld[8]; float nl[8];
#pragma unroll
            for (int k = 0; k < 8; ++k) { const int c = dir ? 63 - (cc + k) : cc + k; ld[k] = *(const v2u*)(base + (size_t)c * 32768); nl[k] = do_n ? nbuf[((size_t)seq * 64 + c) * 128 + tid] : 0.f; }
#pragma unroll
            for (int k = 0; k < 8; ++k) {
                const int c = dir ? 63 - (cc + k) : cc + k;
                const float bl = blam[((size_t)seq * 64 + c) * 2], am = blam[((size_t)seq * 64 + c) * 2 + 1];
                const float mn = fmaxf(bl + m, am), sp = __expf(bl + m - mn), sc = __expf(am - mn);
                v2u o; o.x = cvtpk(st[0], st[1]); o.y = cvtpk(st[2], st[3]);
                if (dry) { o.x = ld[k].x + (__float_as_uint(st[0]) & 0u); o.y = ld[k].y; }
                *(v2u*)(base + (size_t)c * 32768) = o;
                st[0] = sp * st[0] + sc * __uint_as_float(ld[k].x << 16); st[1] = sp * st[1] + sc * __uint_as_float(ld[k].x & 0xffff0000u);
                st[2] = sp * st[2] + sc * __uint_as_float(ld[k].y << 16); st[3] = sp * st[3] + sc * __uint_as_float(ld[k].y & 0xffff0000u);
                if (do_n && !dry) { nbuf[((size_t)seq * 64 + c) * 128 + tid] = nst; nst = sp * nst + sc * nl[k]; }
                if (slab == 0 && tid == 0 && !dry) mprev[seq * 64 + c] = m;
                m = mn;
            }
        }
    }
}

__device__ __forceinline__ void mlstm_out_phase(const bf16* proj, const float* gates, const bf16* kvb, const float* nbuf, const float* mprev, const float* nw, bf16* hs,
                                                LAS unsigned char* lds, int vcu, int G, int tid, const int dry = 0) {
    const int wave = __builtin_amdgcn_readfirstlane(tid >> 6), tb = wave & 3, eh = wave >> 2;
    LAS float* gs = (LAS float*)(lds + XTRA_OFF);
    LAS float* ap = gs + 512; LAS float* Mx = gs + 768; LAS float* inr = gs + 1024; LAS float* cl = gs + 1280; LAS float* qnp = gs + 1536; LAS float* npv = gs + 2560;
    for (int item = vcu; item < 512; item += G) {
        int tid_i = tid; asm volatile("" : "+v"(tid_i));
        const int tid = tid_i, lane = tid & 63, r32 = lane & 31, hh = lane >> 5;
        const int bh = item >> 6, c = item & 63, b = bh >> 2, h = bh & 3, tok0 = b * SEQ + c * 128;
        { const int s = tid & 127, which = tid >> 7; gs[which * 128 + s] = gates[(size_t)(tok0 + s) * 16 + which * 4 + h]; }
        if (tid < 256) npv[tid] = nbuf[((size_t)((tid >> 7) * 8 + bh) * 64 + c) * 128 + (tid & 127)];
#pragma unroll
        for (int i = 0; i < 4; ++i) { const int idx = tid + 512 * i, row = idx >> 4, c16 = idx & 15;
            const bf16* src = proj + (size_t)(tok0 + row) * MP + h * 128 + c16 * 8;
            const v4u q = *(const v4u*)src, k = *(const v4u*)(src + 512);
            *(LAS v2u*)(lds + ML_A + qk8(row, 2 * c16)) = (v2u){q.x, q.y}; *(LAS v2u*)(lds + ML_A + qk8(row, 2 * c16 + 1)) = (v2u){q.z, q.w};
            *(LAS v2u*)(lds + ML_B + qk8(row, 2 * c16)) = (v2u){k.x, k.y}; *(LAS v2u*)(lds + ML_B + qk8(row, 2 * c16 + 1)) = (v2u){k.z, k.w}; }
#pragma unroll
        for (int i = 0; i < 8; ++i) { const int idx = tid + 512 * i, row = idx >> 5, c16 = idx & 31;
            const v4u v = *(const v4u*)(proj + (size_t)(tok0 + row) * MP + 1024 + h * 256 + c16 * 8);
            *(LAS v4u*)(lds + ML_V + vt16(row, c16, 512)) = v; }
        __syncthreads();
        if (dry == 1) { __syncthreads(); continue; }
        if (wave < 2) {
            const int dir = wave, s0 = dir ? 127 - 2 * lane : 2 * lane, s1 = dir ? 126 - 2 * lane : 2 * lane + 1;
            const float li0 = gs[dir * 256 + s0], lf0 = gs[dir * 256 + 128 + s0], li1 = gs[dir * 256 + s1], lf1 = gs[dir * 256 + 128 + s1];
            const float pair = lf0 + lf1, inc = wscan_add(pair), exc = inc - pair, b0 = exc + lf0, b1 = inc;
            const float ap0 = li0 - b0, ap1 = li1 - b1;
            const float incm = wscan_max(fmaxf(ap0, ap1));
            const float excm = wave_shr1(incm, -INFINITY);
            const float pm0 = fmaxf(excm, ap0), pm1 = incm;
            const float mp = mprev[(dir * 8 + bh) * 64 + c];
            const float M0 = fmaxf(mp, pm0), M1 = fmaxf(mp, pm1);
            ap[dir * 128 + s0] = ap0; ap[dir * 128 + s1] = ap1;
            Mx[dir * 128 + s0] = M0; Mx[dir * 128 + s1] = M1;
            inr[dir * 128 + s0] = __expf(mp - M0); inr[dir * 128 + s1] = __expf(mp - M1);
            cl[dir * 128 + s0] = __expf(-(b0 + M0)); cl[dir * 128 + s1] = __expf(-(b1 + M1));
        }
        {
            const int t = tid & 127, qt = tid >> 7; float s0 = 0.f, s1 = 0.f;
#pragma unroll
            for (int g8 = 0; g8 < 8; ++g8) {
                const v2u w = *(LAS const v2u*)(lds + ML_A + qk8(t, 8 * qt + g8));
                const int d = 32 * qt + 4 * g8;
                const float q0 = __uint_as_float(w.x << 16), q1 = __uint_as_float(w.x & 0xffff0000u), q2 = __uint_as_float(w.y << 16), q3 = __uint_as_float(w.y & 0xffff0000u);
                s0 += q0 * npv[d] + q1 * npv[d + 1] + q2 * npv[d + 2] + q3 * npv[d + 3];
                s1 += q0 * npv[128 + d] + q1 * npv[128 + d + 1] + q2 * npv[128 + d + 2] + q3 * npv[128 + d + 3];
            }
            qnp[(qt * 2 + 0) * 128 + t] = s0; qnp[(qt * 2 + 1) * 128 + t] = s1;
        }
        __syncthreads();
        if (dry == 2) { __syncthreads(); continue; }
        bf16x8 qf[8];
#pragma unroll
        for (int ks = 0; ks < 8; ++ks) {
            const v2u lo = *(LAS const v2u*)(lds + ML_A + qk8(32 * tb + r32, 4 * ks + hh)), hi = *(LAS const v2u*)(lds + ML_A + qk8(32 * tb + r32, 4 * ks + 2 + hh));
            qf[ks] = __builtin_bit_cast(bf16x8, (v4u){lo.x, lo.y, hi.x, hi.y});
        }
        const int q4 = (lane & 15) >> 2, lo8 = 8 * (lane & 1), cq = 2 * ((lane >> 4) & 1) + ((lane & 3) >> 1);
        const int tl = 32 * tb + r32;
        bf16x8 pa[5][2]; float rs0 = 0.f, rs1 = 0.f;
        bf16x8 kfa[8], kfb[8];
#define ML_LOADK(i_, dst) do { const int sb_ = (i_) - (((i_) > tb) ? 1 : 0); _Pragma("unroll") for (int ks = 0; ks < 8; ++ks) { \
            const v2u lo = *(LAS const v2u*)(lds + ML_B + qk8(32 * sb_ + r32, 4 * ks + hh)), hi = *(LAS const v2u*)(lds + ML_B + qk8(32 * sb_ + r32, 4 * ks + 2 + hh)); \
            dst[ks] = __builtin_bit_cast(bf16x8, (v4u){lo.x, lo.y, hi.x, hi.y}); } } while (0)
        ML_LOADK(0, kfa);
#pragma unroll
        for (int i = 0; i < 5; ++i) {
            const int dir = (i > tb) ? 1 : 0, sb = i - dir;
            if (i < 4) { if (i & 1) { ML_LOADK(i + 1, kfa); } else { ML_LOADK(i + 1, kfb); } }
            __builtin_amdgcn_sched_barrier(0);
            f32x16 x = (f32x16){};
#pragma unroll
            for (int ks = 0; ks < 8; ++ks) x = __builtin_amdgcn_mfma_f32_32x32x16_bf16((i & 1) ? kfb[ks] : kfa[ks], qf[ks], x, 0, 0, 0);
            const float Mt = Mx[dir * 128 + tl];
            float rsum = 0.f;
#pragma unroll
            for (int r = 0; r < 16; ++r) {
                const int sl = 32 * sb + crow(r, hh);
                const bool ok = dir ? (sl >= tl) : (sl <= tl);
                const float p = ok ? x[r] * __expf(ap[dir * 128 + sl] - Mt) : 0.f;
                x[r] = p; rsum += p;
            }
            if (dir) rs1 += rsum; else rs0 += rsum;
#pragma unroll
            for (int s2 = 0; s2 < 2; ++s2) { v4u w; w.x = cvtpk(x[8 * s2 + 0], x[8 * s2 + 1]); w.y = cvtpk(x[8 * s2 + 2], x[8 * s2 + 3]); w.z = cvtpk(x[8 * s2 + 4], x[8 * s2 + 5]); w.w = cvtpk(x[8 * s2 + 6], x[8 * s2 + 7]); pa[i][s2] = __builtin_bit_cast(bf16x8, w); }
        }
#undef ML_LOADK
        rs0 = xhalf_sum(rs0); rs1 = xhalf_sum(rs1);
        float rd0, rd1, qs0, qs1;
        { const float qn0 = (qnp[0 * 128 + tl] + qnp[2 * 128 + tl]) + (qnp[4 * 128 + tl] + qnp[6 * 128 + tl]);
          const float qn1 = (qnp[1 * 128 + tl] + qnp[3 * 128 + tl]) + (qnp[5 * 128 + tl] + qnp[7 * 128 + tl]);
          const float in0 = inr[tl], in1 = inr[128 + tl];
          rd0 = 1.0f / fmaxf(fabsf(rs0 + in0 * qn0), cl[tl]); rd1 = 1.0f / fmaxf(fabsf(rs1 + in1 * qn1), cl[128 + tl]);
          qs0 = in0 * rd0; qs1 = in1 * rd1; }
#pragma unroll
        for (int i = 0; i < 5; ++i) {
            const float rd = (i > tb) ? rd1 : rd0;
#pragma unroll
            for (int s2 = 0; s2 < 2; ++s2) { float f[8]; unpack8(__builtin_bit_cast(v4u, pa[i][s2]), f);
                v4u w; w.x = cvtpk(f[0] * rd, f[1] * rd); w.y = cvtpk(f[2] * rd, f[3] * rd); w.z = cvtpk(f[4] * rd, f[5] * rd); w.w = cvtpk(f[6] * rd, f[7] * rd); pa[i][s2] = __builtin_bit_cast(bf16x8, w); }
        }
        if (dry == 3) { _Pragma("unroll") for (int i = 0; i < 5; ++i) asm volatile("" :: "v"(pa[i][0]), "v"(pa[i][1])); asm volatile("" :: "v"(qs0), "v"(qs1)); __syncthreads(); continue; }
        f32x16 acc[4];
#pragma unroll
        for (int e = 0; e < 4; ++e) acc[e] = (f32x16){};
        {
            bf16x8 vfa[4], vfb[4];
#define ML_LOADV(st_, dst) do { const int i_ = (st_) >> 1, sb_ = i_ - ((i_ > tb) ? 1 : 0), R0_ = 32 * sb_ + 16 * ((st_) & 1) + 4 * hh + q4; _Pragma("unroll") for (int eb = 0; eb < 4; ++eb) { \
            const int chv_ = 4 * (4 * eh + eb) + cq; dst[eb] = cat8(tr_read(lds + ML_V + vt16(R0_, chv_, 512) + lo8), tr_read(lds + ML_V + vt16(R0_ + 8, chv_, 512) + lo8)); } } while (0)
            ML_LOADV(0, vfa);
#pragma unroll
            for (int st = 0; st < 10; ++st) {
                if (st < 9) { if (st & 1) { ML_LOADV(st + 1, vfa); } else { ML_LOADV(st + 1, vfb); } }
                __builtin_amdgcn_sched_barrier(0);
#pragma unroll
                for (int eb = 0; eb < 4; ++eb) acc[eb] = __builtin_amdgcn_mfma_f32_32x32x16_bf16(pa[st >> 1][st & 1], (st & 1) ? vfb[eb] : vfa[eb], acc[eb], 0, 0, 0);
                __builtin_amdgcn_sched_barrier(0);
            }
#undef ML_LOADV
        }
        if (dry == 4) { asm volatile("" :: "v"(acc[0]), "v"(acc[1]), "v"(acc[2]), "v"(acc[3]), "v"(qs0), "v"(qs1)); __syncthreads(); continue; }
        {
            const char* cb0 = (const char*)(kvb + ((size_t)(0 * 8 + bh) * 64 + c) * 32768 + (size_t)eh * 4096);
            const char* cb1 = (const char*)(kvb + ((size_t)(1 * 8 + bh) * 64 + c) * 32768 + (size_t)eh * 4096);
            const unsigned clo = (unsigned)lane * 16u;
            constexpr int NSET = 5;
            bf16x8 cf[NSET][4];
#define ML_LOADC(ix_, dst) _Pragma("unroll") for (int eb = 0; eb < 4; ++eb) dst[eb] = *(const bf16x8*)((((ix_) >> 3) ? cb1 : cb0) + (unsigned)((((((ix_) & 7) >> 1) * 8 + eb) * 2 + ((ix_) & 1)) * 1024) + clo)
#pragma unroll
            for (int p = 0; p < NSET - 1; ++p) { ML_LOADC(p, cf[p]); }
#pragma unroll
            for (int ix = 0; ix < 16; ++ix) {
                if (ix + NSET - 1 < 16) { ML_LOADC(ix + NSET - 1, cf[(ix + NSET - 1) % NSET]); }
                const float qsc = (ix >> 3) ? qs1 : qs0;
                float f[8]; unpack8(__builtin_bit_cast(v4u, qf[ix & 7]), f);
                v4u w; w.x = cvtpk(f[0] * qsc, f[1] * qsc); w.y = cvtpk(f[2] * qsc, f[3] * qsc); w.z = cvtpk(f[4] * qsc, f[5] * qsc); w.w = cvtpk(f[6] * qsc, f[7] * qsc);
                const bf16x8 qsv = __builtin_bit_cast(bf16x8, w);
                __builtin_amdgcn_sched_barrier(0);
#pragma unroll
                for (int eb = 0; eb < 4; ++eb) acc[eb] = __builtin_amdgcn_mfma_f32_32x32x16_bf16(qsv, cf[ix % NSET][eb], acc[eb], 0, 0, 0);
                __builtin_amdgcn_sched_barrier(0);
            }
#undef ML_LOADC
        }
        if (dry == 5) { asm volatile("" :: "v"(acc[0]), "v"(acc[1]), "v"(acc[2]), "v"(acc[3])); __syncthreads(); continue; }
        v2u ogr[16];
#pragma unroll
        for (int rr = 0; rr < 16; ++rr) ogr[rr] = *(const v2u*)(proj + (size_t)(tok0 + 16 * wave + rr) * MP + 2048 + h * 256 + lane * 4);
        const f32x4 w4 = *(const f32x4*)(nw + h * 256 + lane * 4);
        __syncthreads();
#pragma unroll
        for (int e = 0; e < 4; ++e)
#pragma unroll
            for (int r = 0; r < 16; ++r) *(LAS float*)(lds + (32 * tb + crow(r, hh)) * 1024 + (128 * eh + 32 * e + r32) * 4) = acc[e][r];
        __syncthreads();
#pragma unroll
        for (int rr = 0; rr < 16; ++rr) {
            const int t = 16 * wave + rr;
            const f32x4 v = *(LAS const f32x4*)(lds + t * 1024 + lane * 16);
            const float ss = wave_sum((v.x * v.x + v.y * v.y) + (v.z * v.z + v.w * v.w));
            const float rn = rsqrtf(ss * (1.0f / 256.0f) + EPS);
            const v2u og = ogr[rr];
            const float o0 = __uint_as_float(og.x << 16), o1 = __uint_as_float(og.x & 0xffff0000u), o2 = __uint_as_float(og.y << 16), o3 = __uint_as_float(og.y & 0xffff0000u);
            v2u out;
            out.x = cvtpk(v.x * rn * w4.x / (1.0f + __expf(-o0)), v.y * rn * w4.y / (1.0f + __expf(-o1)));
            out.y = cvtpk(v.z * rn * w4.z / (1.0f + __expf(-o2)), v.w * rn * w4.w / (1.0f + __expf(-o3)));
            *(v2u*)(hs + (size_t)(tok0 + t) * D + h * 256 + lane * 4) = out;
        }
        __syncthreads();
    }
}

#ifndef OPT_ATTN
#define OPT_ATTN 1
#endif
#ifndef OPT_MLSTM
#define OPT_MLSTM 1
#endif
#ifndef PROBE_DUP
#define PROBE_DUP 0
#endif
#ifndef FFN_ALIGN
#define FFN_ALIGN true
#endif
#ifndef ONE_LAUNCH
#define ONE_LAUNCH 1
#endif
constexpr int RTAB_OFF = LDSCTL_OFF + 1024;
typedef unsigned v2u_t __attribute__((ext_vector_type(2)));
__global__ void __launch_bounds__(NWAVES * 64, 2) mk_fwd(Args args) {
    extern __shared__ __attribute__((aligned(16))) unsigned char lds_raw[];
    LAS unsigned char* lds = (LAS unsigned char*)lds_raw;
    volatile LAS unsigned* MISC = (volatile LAS unsigned*)(lds + MISC_OFF);
    const int tid = threadIdx.x; const int wave_s = __builtin_amdgcn_readfirstlane(tid >> 6);
    const int G = gridDim.x; const int bx = blockIdx.x; const int vcu = (G % 8 == 0) ? (bx % 8) * (G / 8) + bx / 8 : bx;
    Ptrs P;
    P.x = args.in[0]; P.pos = (const int*)args.in[1]; P.norm_mix_w = args.in[2]; P.norm_ffn_w = args.in[3]; P.norm_final_w = args.in[4]; P.mlstm_w_in = args.in[5];
    P.mlstm_b_gate = args.in[6]; P.mlstm_norm_w = args.in[7]; P.mlstm_w_out = args.in[8]; P.attn_w_in = args.in[9]; P.attn_sink = args.in[10]; P.attn_w_out = args.in[11];
    P.ffn_w_in = args.in[12]; P.ffn_w_out = args.in[13]; P.out = args.out; P.ws = args.ws;
    unsigned char* ws = args.ws;
    gu32* ctl = (gu32*)(ws + WS_CTL);
    for (int u = tid; u < (LDS_BYTES - LDSCTL_OFF) / 4; u += NWAVES * 64) ((LAS unsigned*)(lds + LDSCTL_OFF))[u] = 0u;
    __syncthreads();
    const int lo = args.ph_lo, hi = args.ph_hi;
    XcdBarrier bar; bar.bar = (unsigned*)(ctl + CW_BAR); bar.x = 0; bar.st = nullptr;
    if (hi - lo > 1) bar = xcd_barrier_post((unsigned*)(ctl + CW_BAR), MISC + 8);
    int ph = 0;
#define PH_ON (ph >= lo && ph < hi)
#define PH_IDS int tid_p; asm volatile("v_mbcnt_lo_u32_b32 %0, -1, 0\n\tv_mbcnt_hi_u32_b32 %0, -1, %0" : "=v"(tid_p)); tid_p += wave_s * 64; asm volatile("" : "+v"(tid_p)); const int lane = tid_p & 63, wave = __builtin_amdgcn_readfirstlane(tid_p >> 6); (void)lane; (void)wave
#define REP(bit) for (int rep_ = 0; rep_ < 1 + ((args.dup >> (bit)) & 1); ++rep_)
#define PH_END do { if (ph >= lo && ph + 1 < hi) xcd_barrier(bar); ++ph; } while (0)

    bf16* xb = (bf16*)(ws + WS_XB); bf16* hs = (bf16*)(ws + WS_HS); bf16* proj = (bf16*)(ws + WS_PROJ);
    float* part = (float*)(ws + WS_PART);
    const float* cosT = (const float*)(ws + WS_ROPE); const float* sinT = cosT + (size_t)M * 32;

    if (PH_ON) REP(4) { PH_IDS; p0_prologue(P, lds, vcu, G, wave, lane); }
    PH_END;
#if PROBE_DUP & 64
    if (hi - lo > 1) for (int xb_ = 0; xb_ < 10; ++xb_) xcd_barrier(bar);
#endif

    for (int L = 0; L < 4; ++L) {
        const int j = L >> 1;
        if ((L & 1) == 0) {
            if (PH_ON) {
                for (int rep_ = 0; rep_ < 1 + ((args.dup >> 20) & 1) * 4; ++rep_) { PH_IDS; for (int gb = bx; gb < M / 64; gb += G) gates_step(P, j, lds, gb, wave, lane); }
                pg8::Gemm g{xb, (const bf16*)(ws + W_MIN) + (size_t)j * MP * D, M, MP, D}; pg8::StaticOrder S; S.init(M, MP, G, bx);
                { PH_IDS; pg8::rstd_table_fill(part, S, (LAS float*)(lds + RTAB_OFF), tid_p); }
                pg8::EpiProj<false> E{proj, MP, (const LAS float*)(lds + RTAB_OFF), nullptr, nullptr};
                REP(1) pg8::gemm_phase<pg8::EpiProj<false>, pg8::StaticOrder, true, true>(lds + RING_OFF, g, S, E, wave_s);
            }
            PH_END;
            if (PH_ON) REP(2) { PH_IDS; mlstm_chunk_phase(proj, (const float*)(ws + WS_GATES), (bf16*)(ws + WS_KV), (float*)(ws + WS_NBUF), (float*)(ws + WS_SMALL), lds, vcu, G, tid_p); }
            PH_END;
            if (PH_ON) { PH_IDS; mlstm_scan_phase((bf16*)(ws + WS_KV), (float*)(ws + WS_NBUF), (const float*)(ws + WS_SMALL), (float*)(ws + WS_SMALL + 16384), bx, G, tid_p); }
#if PROBE_DUP & 0x80000
            if (PH_ON) { PH_IDS; mlstm_scan_phase((bf16*)(ws + WS_KV), (float*)(ws + WS_NBUF), (const float*)(ws + WS_SMALL), (float*)(ws + WS_SMALL + 16384), bx, G, tid_p, 1); }
#endif
            PH_END;
            if (PH_ON) REP(5) { PH_IDS; mlstm_out_phase(proj, (const float*)(ws + WS_GATES), (const bf16*)(ws + WS_KV), (const float*)(ws + WS_NBUF), (const float*)(ws + WS_SMALL + 16384), P.mlstm_norm_w + j * D, hs, lds, vcu, G, tid_p); }
#if PROBE_DUP & 0x70000
            if (PH_ON) { PH_IDS; mlstm_out_phase(proj, (const float*)(ws + WS_GATES), (const bf16*)(ws + WS_KV), (const float*)(ws + WS_NBUF), (const float*)(ws + WS_SMALL + 16384), P.mlstm_norm_w + j * D, hs, lds, vcu, G, tid_p, (PROBE_DUP >> 16) & 7); }
#endif
            PH_END;
        } else {
            if (PH_ON) {
                pg8::Gemm g{xb, (const bf16*)(ws + W_AIN) + (size_t)j * AW * D, M, AW, D}; pg8::StaticOrder S; S.init(M, AW, G, bx);
                { PH_IDS; pg8::rstd_table_fill(part, S, (LAS float*)(lds + RTAB_OFF), tid_p); }
                pg8::EpiProj<true> E{proj, AW, (const LAS float*)(lds + RTAB_OFF), cosT, sinT};
                REP(1) pg8::gemm_phase<pg8::EpiProj<true>, pg8::StaticOrder, true, true>(lds + RING_OFF, g, S, E, wave_s);
            }
            PH_END;
            if (PH_ON) REP(3) { PH_IDS; attn_phase(proj, P.attn_sink + j * 16, hs, lds, vcu, G, tid_p); }
#if PROBE_DUP & 512
            if (PH_ON) { PH_IDS; attn_phase(proj, P.attn_sink + j * 16, hs, lds, vcu, G, tid_p, 1); }
#endif
#if PROBE_DUP & 1024
            if (PH_ON) { PH_IDS; attn_phase(proj, P.attn_sink + j * 16, hs, lds, vcu, G, tid_p, 2); }
#endif

            PH_END;
        }
        if (PH_ON) {
            const bf16* wo = (L & 1) ? (const bf16*)(ws + W_AOUT) + (size_t)j * D * D : (const bf16*)(ws + W_MOUT) + (size_t)j * D * D;
            pg8::Gemm g{hs, wo, M, D, D}; pg8::StaticOrder S; S.init(M, D, G, bx);
#if PROBE_DUP & 256
            { pg8::EpiNull EN; pg8::gemm_phase<pg8::EpiNull, pg8::StaticOrder, true, true>(lds + RING_OFF, g, S, EN, wave_s); }
#endif
            pg8::EpiResid E{xb, part};
            pg8::gemm_phase<pg8::EpiResid, pg8::StaticOrder, true, true>(lds + RING_OFF, g, S, E, wave_s);
        }
        PH_END;
        if (PH_ON) {
            pg8::Gemm g{xb, (const bf16*)(ws + W_FIN) + (size_t)L * 2 * DFF * D, M, 2 * DFF, D}; pg8::StaticOrder S; S.init(M, 2 * DFF, G, bx);
#if PROBE_DUP & 8192
            { pg8::EpiSwiGLU EN{proj, DFF, nullptr}; pg8::gemm_phase<pg8::EpiSwiGLU, pg8::StaticOrder, true, true>(lds + RING_OFF, g, S, EN, wave_s); }
#endif
#if PROBE_DUP & 4096
            { pg8::EpiNull EN; pg8::gemm_phase<pg8::EpiNull, pg8::StaticOrder, true, true>(lds + RING_OFF, g, S, EN, wave_s); }
#endif
            { PH_IDS; pg8::rstd_table_fill(part, S, (LAS float*)(lds + RTAB_OFF), tid_p); }
            pg8::EpiSwiGLU E{proj, DFF, (const LAS float*)(lds + RTAB_OFF)};
            REP(0) pg8::gemm_phase<pg8::EpiSwiGLU, pg8::StaticOrder, FFN_ALIGN, true>(lds + RING_OFF, g, S, E, wave_s);
        }
        PH_END;
        if (PH_ON) {
            pg8::Gemm g{proj, (const bf16*)(ws + W_FOUT) + (size_t)L * D * DFF, M, D, DFF}; pg8::StaticOrder S; S.init(M, D, G, bx);
#if PROBE_DUP & 128
            { pg8::EpiNull EN; pg8::gemm_phase<pg8::EpiNull, pg8::StaticOrder, true, true>(lds + RING_OFF, g, S, EN, wave_s); }
#endif
            pg8::EpiResid E{xb, part};
            pg8::gemm_phase<pg8::EpiResid, pg8::StaticOrder, true, true>(lds + RING_OFF, g, S, E, wave_s);
        }
        PH_END;
    }
    if (PH_ON) {
        PH_IDS;
        const int gw = vcu * NWAVES + wave, NGW = G * NWAVES;
        for (int m = gw; m < M; m += NGW) {
            float s = lane < 16 ? part[(size_t)m * 16 + lane] : 0.f;
            s = wave_sum(s);
            const float rstd = rsqrtf(s * (1.0f / 1024.0f) + EPS);
            GAS f32x4* orow = (GAS f32x4*)(P.out + (size_t)m * D) + lane;
            const GAS f32x4* wr = (const GAS f32x4*)P.norm_final_w + lane;
            const GAS v2u_t* xr = (const GAS v2u_t*)(xb + (size_t)m * D) + lane;
#pragma unroll
            for (int jj = 0; jj < 4; ++jj) { const v2u_t xv = xr[64 * jj]; const f32x4 w = wr[64 * jj];
                f32x4 v = {__uint_as_float(xv.x << 16), __uint_as_float(xv.x & 0xffff0000u), __uint_as_float(xv.y << 16), __uint_as_float(xv.y & 0xffff0000u)};
                v = v * rstd * w; orow[64 * jj] = v; }
        }
    }
    PH_END;
}

#if !ONE_LAUNCH
namespace nv {
constexpr int TCH = 32;
__global__ void __launch_bounds__(272) k_mlstm_rec(const bf16* __restrict__ proj, const float* __restrict__ gates, bf16* __restrict__ hf, bf16* __restrict__ hb) {
    __shared__ float sq[TCH][128], sk[TCH][128], sv[TCH][17], sli[TCH], slf[TCH];
    __shared__ float red[2][16][17];
    const int es = blockIdx.x, h = blockIdx.y, b = blockIdx.z >> 1, dir = blockIdx.z & 1;
    const int tid = threadIdx.x, e = tid % 17, dg = tid / 17;
    float C[8];
#pragma unroll
    for (int j = 0; j < 8; ++j) C[j] = 0.f;
    float m = 0.f;
    bf16* hout = dir ? hb : hf;
    int par = 0;
    for (int c0 = 0; c0 < SEQ; c0 += TCH) {
        __syncthreads();
        for (int i = tid; i < TCH * 128; i += 272) {
            const int tt = i >> 7, d = i & 127;
            const int t = dir ? (SEQ - 1 - (c0 + tt)) : (c0 + tt);
            const bf16* row = proj + (size_t)(b * SEQ + t) * MP;
            sq[tt][d] = bf2f(row[h * 128 + d]);
            sk[tt][d] = bf2f(row[512 + h * 128 + d]);
        }
        for (int i = tid; i < TCH * 17; i += 272) {
            const int tt = i / 17, ee = i % 17;
            const int t = dir ? (SEQ - 1 - (c0 + tt)) : (c0 + tt);
            const bf16* row = proj + (size_t)(b * SEQ + t) * MP;
            sv[tt][ee] = ee < 16 ? bf2f(row[1024 + h * 256 + es * 16 + ee]) : 1.0f;
        }
        if (tid < TCH) {
            const int t = dir ? (SEQ - 1 - (c0 + tid)) : (c0 + tid);
            const float* row = gates + (size_t)(b * SEQ + t) * 16;
            sli[tid] = row[(dir ? 8 : 0) + h];
            slf[tid] = row[(dir ? 12 : 4) + h];
        }
        __syncthreads();
        for (int tt = 0; tt < TCH; ++tt) {
            const float li = sli[tt], lf = slf[tt];
            const float mn = fmaxf(lf + m, li);
            const float fs = expf(lf + m - mn), is = expf(li - mn);
            m = mn;
            const float vv = sv[tt][e] * is;
            float partv = 0.f;
#pragma unroll
            for (int j = 0; j < 8; ++j) {
                const int d = dg * 8 + j;
                C[j] = fs * C[j] + sk[tt][d] * vv;
                partv += sq[tt][d] * C[j];
            }
            red[par][dg][e] = partv;
            __syncthreads();
            if (tid < 16) {
                float num = 0.f, qn = 0.f;
#pragma unroll
                for (int g = 0; g < 16; ++g) { num += red[par][g][tid]; qn += red[par][g][16]; }
                const float den = fmaxf(fabsf(qn), expf(-m));
                const int t = dir ? (SEQ - 1 - (c0 + tt)) : (c0 + tt);
                hout[(size_t)(b * SEQ + t) * D + h * 256 + es * 16 + tid] = (bf16)f2bf(num / den);
            }
            par ^= 1;
        }
    }
}
__global__ void k_mlstm_post(const bf16* __restrict__ hf, const bf16* __restrict__ hb, const bf16* __restrict__ proj, const float* __restrict__ nw, bf16* __restrict__ out) {
    const int row = blockIdx.x, tid = threadIdx.x, h = tid >> 6, lane = tid & 63;
    const size_t off = (size_t)row * D + h * 256 + lane * 4;
    float v[4]; float s = 0.f;
#pragma unroll
    for (int c = 0; c < 4; ++c) { v[c] = bf2f(hf[off + c]) + bf2f(hb[off + c]); s += v[c] * v[c]; }
    for (int o = 32; o > 0; o >>= 1) s += __shfl_xor(s, o);
    const float r = rsqrtf(s * (1.0f / 256.0f) + EPS);
#pragma unroll
    for (int c = 0; c < 4; ++c) {
        const float og = bf2f(proj[(size_t)row * MP + 2048 + h * 256 + lane * 4 + c]);
        out[off + c] = (bf16)f2bf(v[c] * r * nw[h * 256 + lane * 4 + c] / (1.0f + expf(-og)));
    }
}
__global__ void __launch_bounds__(64) k_attn(const bf16* __restrict__ proj, const float* __restrict__ sink, bf16* __restrict__ out) {
    const int idx = blockIdx.x * 64 + threadIdx.x;
    const int hq = idx / M, tok = idx % M;
    const int b = tok / SEQ, i = tok % SEQ, hkv = hq >> 2;
    float q[64], acc[64];
    const bf16* qp = proj + (size_t)tok * AW + hq * 64;
#pragma unroll
    for (int d = 0; d < 64; ++d) { q[d] = bf2f(qp[d]); acc[d] = 0.f; }
    float m = sink[hq], l = 1.0f;
    const int j0 = max(0, i - 128), j1 = min(SEQ - 1, i + 128);
    for (int jx = j0; jx <= j1; ++jx) {
        const bf16* kp = proj + (size_t)(b * SEQ + jx) * AW + 1024 + hkv * 64;
        const bf16* vp = kp + 256;
        float s = 0.f;
#pragma unroll
        for (int d = 0; d < 64; ++d) s += q[d] * bf2f(kp[d]);
        if (s > m) {
            const float f = expf(m - s);
            l *= f;
#pragma unroll
            for (int d = 0; d < 64; ++d) acc[d] *= f;
            m = s;
        }
        const float p = expf(s - m);
        l += p;
#pragma unroll
        for (int d = 0; d < 64; ++d) acc[d] += p * bf2f(vp[d]);
    }
    const float rl = 1.0f / l;
    bf16* op = out + (size_t)tok * D + hq * 64;
#pragma unroll
    for (int d = 0; d < 64; ++d) op[d] = (bf16)f2bf(acc[d] * rl);
}
}
#endif

extern "C" void kernel_launch(void* const* d_in, const int* in_sizes, int n_in, void* d_out, int out_size, void* d_ws, size_t ws_size, hipStream_t stream) {
    static int grid = 0;
    if (grid == 0) {
        int dev = 0, cus = 0;
        if (hipGetDevice(&dev) != hipSuccess || hipDeviceGetAttribute(&cus, hipDeviceAttributeMultiprocessorCount, dev) != hipSuccess) { fprintf(stderr, "kernel_launch: device query failed\n"); grid = -1; return; }
        if (hipFuncSetAttribute((const void*)mk_fwd, hipFuncAttributeMaxDynamicSharedMemorySize, LDS_BYTES) != hipSuccess) { fprintf(stderr, "kernel_launch: hipFuncSetAttribute failed\n"); grid = -1; return; }
        if (ws_size < WS_END) { fprintf(stderr, "kernel_launch: workspace too small: %zu < %zu\n", ws_size, (size_t)WS_END); grid = -1; return; }
        (void)hipGetLastError();
        grid = cus;
    }
    if (grid < 0) return;
    (void)hipMemsetAsync((char*)d_ws + WS_CTL, 0, CTL_ZERO_BYTES, stream);
    Args a{};
    for (int i = 0; i < 14; ++i) a.in[i] = (const float*)d_in[i];
    a.out = (float*)d_out; a.ws = (unsigned char*)d_ws; a.dup = PROBE_DUP;
    unsigned char* ws = (unsigned char*)d_ws;
    int ph = 0;
    auto launch = [&](int lo, int hi) { a.ph_lo = lo; a.ph_hi = hi; hipLaunchKernelGGL(mk_fwd, dim3(grid), dim3(NWAVES * 64), LDS_BYTES, stream, a); };
#if ONE_LAUNCH
    launch(0, 1000);
#else
    launch(ph, ph + 1); ++ph;
    for (int L = 0; L < 4; ++L) {
        const int j = L >> 1;
        launch(ph, ph + 1); ++ph;
        if ((L & 1) == 0) {
#if OPT_MLSTM
            launch(ph, ph + 1); launch(ph + 1, ph + 2); launch(ph + 2, ph + 3);
#else
            bf16* hf = (bf16*)(ws + WS_KV); bf16* hb = hf + (size_t)M * D;
            hipLaunchKernelGGL(nv::k_mlstm_rec, dim3(16, 4, 4), dim3(272), 0, stream, (const bf16*)(ws + WS_PROJ), (const float*)(ws + WS_GATES), hf, hb);
            hipLaunchKernelGGL(nv::k_mlstm_post, dim3(M), dim3(256), 0, stream, (const bf16*)hf, (const bf16*)hb, (const bf16*)(ws + WS_PROJ), (const float*)d_in[7] + j * D, (bf16*)(ws + WS_HS));
#endif
            ph += 3;
        } else {
#if OPT_ATTN
            launch(ph, ph + 1);
#else
            hipLaunchKernelGGL(nv::k_attn, dim3(M * 16 / 64), dim3(64), 0, stream, (const bf16*)(ws + WS_PROJ), (const float*)d_in[10] + j * 16, (bf16*)(ws + WS_HS));
#endif
            ph += 1;
        }
        launch(ph, ph + 1); ++ph;
        launch(ph, ph + 1); ++ph;
        launch(ph, ph + 1); ++ph;
    }
    launch(ph, ph + 1); ++ph;
#endif
}
```
